# Optimizing an MI355X kernel written in HIP

```python
import math
import jax, jax.numpy as jnp
from jax import lax
import numpy as np

D_MODEL = 1024
BATCH = 2
SEQ = 16384
DEPTH = 4

N_A = DEPTH // 2
N_B = DEPTH - N_A

GLA_HEADS = 4
GLA_KD = D_MODEL // 2
GLA_VD = D_MODEL
GLA_DK = GLA_KD // GLA_HEADS
GLA_DV = GLA_VD // GLA_HEADS
GLA_RANK = 16
GLA_TAU = 16.0
GLA_CHUNK = 64

FOX_HEADS = 16
FOX_HEAD_DIM = 64
FOX_WIDTH = FOX_HEADS * FOX_HEAD_DIM
FOX_BLOCK = 128

D_FF = 2816
PLE_DIM = 256
LN_EPS = 1e-5
DEEPNORM_ALPHA = (2 * DEPTH) ** 0.25
DEEPNORM_BETA = (8 * DEPTH) ** -0.25

kernel_name = "yoco_gla_fox_macaron_deepnorm"


def layer_norm(x, g, b):
    xf = x.astype(jnp.float32)
    mu = jnp.mean(xf, axis=-1, keepdims=True)
    var = jnp.mean(jnp.square(xf - mu), axis=-1, keepdims=True)
    return ((xf - mu) * lax.rsqrt(var + LN_EPS) * g + b).astype(x.dtype)


def swiglu(x, w_in, w_out):
    g, u = jnp.split(x @ w_in, 2, axis=-1)
    return (jax.nn.silu(g) * u) @ w_out


def _to_chunks(t, hd):
    b, s, _ = t.shape
    return t.reshape(b, s // GLA_CHUNK, GLA_CHUNK, GLA_HEADS, hd).transpose(0, 3, 1, 2, 4)


def gla_mixer(x, w_in, w_a2, b_a, gn_g, gn_b, w_o):
    bsz, s, _ = x.shape
    proj = x @ w_in
    q, k, v, r, a_lr = jnp.split(
        proj, [GLA_KD, 2 * GLA_KD, 2 * GLA_KD + GLA_VD, 2 * GLA_KD + 2 * GLA_VD], axis=-1)
    log_a = jax.nn.log_sigmoid((a_lr @ w_a2).astype(jnp.float32) + b_a) / GLA_TAU

    q = _to_chunks(q * (GLA_DK ** -0.5), GLA_DK)
    k = _to_chunks(k, GLA_DK)
    v = _to_chunks(v, GLA_DV)
    bcum = jnp.cumsum(_to_chunks(log_a, GLA_DK), axis=3)
    b_last = bcum[..., -1:, :]

    q_dec = q * jnp.exp(bcum)
    k_intra = k * jnp.exp(-bcum)
    k_state = k * jnp.exp(b_last - bcum)

    causal = jnp.tril(jnp.ones((GLA_CHUNK, GLA_CHUNK), dtype=bool))
    attn = jnp.einsum('bhncd,bhnsd->bhncs', q_dec, k_intra)
    attn = jnp.where(causal, attn, 0.0)
    o_intra = jnp.einsum('bhncs,bhnsv->bhncv', attn, v.astype(attn.dtype))

    def step(state, inp):
        q_c, k_c, v_c, dec_c = inp
        o_c = jnp.einsum('bhcd,bhdv->bhcv', q_c, state)
        state = state * dec_c[..., None] + jnp.einsum('bhcd,bhcv->bhdv', k_c, v_c.astype(state.dtype))
        return state, o_c

    state0 = jnp.zeros((bsz, GLA_HEADS, GLA_DK, GLA_DV), dtype=q_dec.dtype)
    xs = (jnp.moveaxis(q_dec, 2, 0), jnp.moveaxis(k_state, 2, 0),
          jnp.moveaxis(v, 2, 0), jnp.moveaxis(jnp.exp(b_last[..., 0, :]), 2, 0))
    _, o_inter = lax.scan(step, state0, xs)
    o = o_intra + jnp.moveaxis(o_inter, 0, 2)

    o = o.transpose(0, 2, 3, 1, 4).reshape(bsz, s, GLA_HEADS, GLA_DV)
    o = layer_norm(o, gn_g.reshape(GLA_HEADS, GLA_DV), gn_b.reshape(GLA_HEADS, GLA_DV))
    o = o.reshape(bsz, s, GLA_VD).astype(x.dtype) * jax.nn.silu(r)
    return o @ w_o


def fox_shared_kv(h, w_kvf, b_f):
    bsz, s, _ = h.shape
    kvf = h @ w_kvf
    k, v, f_logit = jnp.split(kvf, [FOX_WIDTH, 2 * FOX_WIDTH], axis=-1)
    log_f = jax.nn.log_sigmoid(f_logit.astype(jnp.float32) + b_f)
    c = jnp.cumsum(log_f, axis=1).transpose(0, 2, 1)
    k = k.reshape(bsz, s, FOX_HEADS, FOX_HEAD_DIM).transpose(0, 2, 1, 3)
    v = v.reshape(bsz, s, FOX_HEADS, FOX_HEAD_DIM).transpose(0, 2, 1, 3)
    return k, v, c


def fox_mixer(x, k, v, c, w_in, w_o):
    bsz, s, _ = x.shape
    q, g = jnp.split(x @ w_in, 2, axis=-1)
    q = (q * (FOX_HEAD_DIM ** -0.5)).reshape(bsz, s, FOX_HEADS, FOX_HEAD_DIM).transpose(0, 2, 1, 3)
    nb = s // FOX_BLOCK
    q_blocks = q.reshape(bsz, FOX_HEADS, nb, FOX_BLOCK, FOX_HEAD_DIM).transpose(2, 0, 1, 3, 4)
    c_blocks = c.reshape(bsz, FOX_HEADS, nb, FOX_BLOCK).transpose(2, 0, 1, 3)
    k_pos = jnp.arange(s)

    def one_block(args):
        qb, cb, start = args
        logits = jnp.einsum('bhqd,bhkd->bhqk', qb, k).astype(jnp.float32)
        logits = logits + cb[..., :, None] - c[:, :, None, :]
        q_pos = start + jnp.arange(FOX_BLOCK)
        logits = jnp.where(k_pos[None, :] <= q_pos[:, None], logits, -jnp.inf)
        probs = jax.nn.softmax(logits, axis=-1)
        return jnp.einsum('bhqk,bhkd->bhqd', probs.astype(v.dtype), v)

    o = lax.map(one_block, (q_blocks, c_blocks, jnp.arange(nb) * FOX_BLOCK))
    o = o.transpose(1, 0, 3, 2, 4).reshape(bsz, s, FOX_WIDTH)
    o = o * jax.nn.sigmoid(g)
    return o @ w_o


def setup_inputs(seed: int = 0) -> dict:
    key = jax.random.key(seed)
    ks = jax.random.split(key, 32)
    f32 = jnp.float32

    def nrm(k, shape, fan_in, scale=1.0):
        return jax.random.normal(k, shape, f32) * (scale * fan_in ** -0.5)

    def gain(k, shape):
        return 1.0 + 0.02 * jax.random.normal(k, shape, f32)

    def bias(k, shape):
        return 0.02 * jax.random.normal(k, shape, f32)

    gla_in_width = 2 * GLA_KD + 2 * GLA_VD + GLA_RANK
    return {
        "x": jax.random.normal(ks[0], (BATCH, SEQ, D_MODEL), f32),
        "p": jax.random.normal(ks[1], (DEPTH, BATCH, SEQ, PLE_DIM), f32),
        "ffn1_w_in": nrm(ks[2], (DEPTH, D_MODEL, 2 * D_FF), D_MODEL),
        "ffn1_w_out": nrm(ks[3], (DEPTH, D_FF, D_MODEL), D_FF, DEEPNORM_BETA),
        "ln1_g": gain(ks[4], (DEPTH, D_MODEL)),
        "ln1_b": bias(ks[5], (DEPTH, D_MODEL)),
        "gla_w_in": nrm(ks[6], (N_A, D_MODEL, gla_in_width), D_MODEL),
        "gla_w_a2": nrm(ks[7], (N_A, GLA_RANK, GLA_KD), GLA_RANK),
        "gla_b_a": bias(ks[8], (N_A, GLA_KD)),
        "gla_gn_g": gain(ks[9], (N_A, GLA_VD)),
        "gla_gn_b": bias(ks[10], (N_A, GLA_VD)),
        "gla_w_o": nrm(ks[11], (N_A, GLA_VD, D_MODEL), GLA_VD, DEEPNORM_BETA),
        "fox_w_kvf": nrm(ks[12], (D_MODEL, 2 * FOX_WIDTH + FOX_HEADS), D_MODEL),
        "fox_b_f": 2.0 + 2.0 * jax.random.uniform(ks[13], (FOX_HEADS,), f32),
        "fox_w_in": nrm(ks[14], (N_B, D_MODEL, 2 * FOX_WIDTH), D_MODEL),
        "fox_w_o": nrm(ks[15], (N_B, FOX_WIDTH, D_MODEL), FOX_WIDTH, DEEPNORM_BETA),
        "ln2_g": gain(ks[16], (DEPTH, D_MODEL)),
        "ln2_b": bias(ks[17], (DEPTH, D_MODEL)),
        "ffn2_w_in": nrm(ks[18], (DEPTH, D_MODEL, 2 * D_FF), D_MODEL),
        "ffn2_w_out": nrm(ks[19], (DEPTH, D_FF, D_MODEL), D_FF, DEEPNORM_BETA),
        "ple_w_gate": nrm(ks[20], (DEPTH, D_MODEL, D_MODEL), D_MODEL),
        "ple_w_proj": nrm(ks[21], (DEPTH, PLE_DIM, D_MODEL), PLE_DIM, DEEPNORM_BETA),
        "ln3_g": gain(ks[22], (DEPTH, D_MODEL)),
        "ln3_b": bias(ks[23], (DEPTH, D_MODEL)),
    }


def reference(x, p, ffn1_w_in, ffn1_w_out, ln1_g, ln1_b, gla_w_in, gla_w_a2, gla_b_a, gla_gn_g,
              gla_gn_b, gla_w_o, fox_w_kvf, fox_b_f, fox_w_in, fox_w_o, ln2_g, ln2_b,
              ffn2_w_in, ffn2_w_out, ple_w_gate, ple_w_proj, ln3_g, ln3_b):
    k_sh = v_sh = c_sh = None
    for i in range(DEPTH):
        if i == N_A:
            k_sh, v_sh, c_sh = fox_shared_kv(x, fox_w_kvf, fox_b_f)
        x = layer_norm(DEEPNORM_ALPHA * x + 0.5 * swiglu(x, ffn1_w_in[i], ffn1_w_out[i]),
                       ln1_g[i], ln1_b[i])
        if i < N_A:
            mix = gla_mixer(x, gla_w_in[i], gla_w_a2[i], gla_b_a[i], gla_gn_g[i], gla_gn_b[i], gla_w_o[i])
        else:
            j = i - N_A
            mix = fox_mixer(x, k_sh, v_sh, c_sh, fox_w_in[j], fox_w_o[j])
        x = layer_norm(DEEPNORM_ALPHA * x + mix, ln2_g[i], ln2_b[i])
        ple = jax.nn.sigmoid(x @ ple_w_gate[i]) * (p[i] @ ple_w_proj[i])
        x = layer_norm(DEEPNORM_ALPHA * x + 0.5 * swiglu(x, ffn2_w_in[i], ffn2_w_out[i]) + ple,
                       ln3_g[i], ln3_b[i])
    return x
```

```cpp
#include <hip/hip_runtime.h>
#include <hip/hip_cooperative_groups.h>
#include <cstdio>
#include <cstdint>
namespace cg = cooperative_groups;
namespace pg8 {
#define PG8_LAS __attribute__((address_space(3)))
typedef unsigned short bf16_t;
typedef short bf16x8 __attribute__((ext_vector_type(8)));
typedef float f32x4 __attribute__((ext_vector_type(4)));
typedef unsigned u32x4 __attribute__((ext_vector_type(4)));
constexpr int BM = 256, BK = 64, HALF = 128, HTB = HALF * BK * 2  , STAGE_BYTES = 8 * HTB, NXCD = 8, WGM = 8;

__host__ __device__ __forceinline__ int lds_byte(int r, int c) { const int st = (r >> 4) * 2 + (c >> 5), rr = r & 15, cc = c & 31, ob = rr * 64 + cc * 2; return st * 1024 + (ob ^ (((ob >> 9) & 1) << 5)); }
__host__ __device__ __forceinline__ void stage_rc(int b, int& R, int& C) { const int st = b / 1024, sb = b % 1024, swz = sb ^ (((sb >> 9) & 1) << 5); R = (st >> 1) * 16 + swz / 64; C = (st & 1) * 32 + (swz % 64) / 2; }
__host__ __device__ __forceinline__ int perm32(int rho) { const int n = rho >> 4, i = rho & 15; return 8 * (i >> 2) + 4 * n + (i & 3); }

struct Unit { int pm, pn; };
struct Gemm { const bf16_t* A; const bf16_t* Bt; int M, N, K; };

struct StaticOrder {
    int nM, nN, nwg, G, c;
    __host__ __device__ void init(int M, int N, int G_, int c_) { nM = M / BM; nN = N / BM; nwg = nM * nN; G = G_; c = c_; }
    __host__ __device__ bool next(int i, Unit& u) const {
        const long L = (long)i * G + c; if (L >= nwg) return false;
        int wgid = (int)L; { const int q = nwg / NXCD, r = nwg % NXCD, xcd = wgid % NXCD, off = wgid / NXCD; wgid = (xcd < r ? xcd * (q + 1) : r * (q + 1) + (xcd - r) * q) + off; }
        const int nig = WGM * nN, gid = wgid / nig, fm = gid * WGM, gsz = (nM - fm) < WGM ? (nM - fm) : WGM;
        u.pm = fm + ((wgid % nig) % gsz); u.pn = (wgid % nig) / gsz; return true;
    }
    __device__ __forceinline__ void a_ready(const Unit&) const {}
    __device__ __forceinline__ void done(const Unit&) const {}
};

__device__ __forceinline__ unsigned cvt_pk_bf16(float lo, float hi) { unsigned r; asm volatile("v_cvt_pk_bf16_f32 %0, %1, %2" : "=v"(r) : "v"(lo), "v"(hi)); return r; }
__device__ __forceinline__ float fsigmoid(float x) { return __builtin_amdgcn_rcpf(1.f + __builtin_amdgcn_exp2f(-1.4426950408889634f * x)); }
__device__ __forceinline__ float bf_lo(unsigned w) { return __uint_as_float(w << 16); }
__device__ __forceinline__ float bf_hi(unsigned w) { return __uint_as_float(w & 0xffff0000u); }
__device__ __forceinline__ float flogsig(float z) { return fminf(z, 0.f) - __logf(1.f + __expf(-fabsf(z))); }
typedef unsigned u32x2 __attribute__((ext_vector_type(2)));
#define EPI_IDS() { int t_ = threadIdx.x; asm volatile("" : "+v"(t_)); const int l_ = t_ & 63, w_ = __builtin_amdgcn_readfirstlane(t_ >> 6); wr = w_ >> 2; wc = w_ & 3; fr = l_ & 15; fq = l_ >> 4; }


struct EpiSwiGLU {
    static constexpr bool PERM = true, AFTER_DRAIN = false;
    bf16_t* H; int ldh;
    __device__ __forceinline__ void operator()(const f32x4 (&acc)[2][2][4][2], const Unit& u, int wr, int wc, int fr, int fq) const {
        EPI_IDS();
        const int row0 = u.pm * BM + wr * 64 + fr, col0 = u.pn * HALF + wc * 32 + 8 * fq;
#pragma unroll
        for (int ai = 0; ai < 2; ++ai)
#pragma unroll
            for (int m = 0; m < 4; ++m) {
                bf16_t* p = H + (size_t)(row0 + ai * HALF + m * 16) * ldh + col0;
                const f32x4 g0 = acc[ai][0][m][0], g1 = acc[ai][0][m][1], u0 = acc[ai][1][m][0], u1 = acc[ai][1][m][1];
                float h[8];
#pragma unroll
                for (int j = 0; j < 4; ++j) { h[j] = g0[j] * fsigmoid(g0[j]) * u0[j]; h[4 + j] = g1[j] * fsigmoid(g1[j]) * u1[j]; }
                u32x4 w; w.x = cvt_pk_bf16(h[0], h[1]); w.y = cvt_pk_bf16(h[2], h[3]); w.z = cvt_pk_bf16(h[4], h[5]); w.w = cvt_pk_bf16(h[6], h[7]);
                *(u32x4*)p = w;
            }
    }
};
struct EpiRes {
    static constexpr bool PERM = false, AFTER_DRAIN = false;
    const float* base; float* out; const bf16_t* add; float alpha, s;
    __device__ __forceinline__ void operator()(const f32x4 (&acc)[2][2][4][2], const Unit& u, int wr, int wc, int fr, int fq) const {
        EPI_IDS();
        const int row0 = u.pm * BM + wr * 64 + fr, col0 = u.pn * BM + wc * 32 + 4 * fq;
#pragma unroll
        for (int ai = 0; ai < 2; ++ai)
#pragma unroll
            for (int m = 0; m < 4; ++m) {
                const size_t off = (size_t)(row0 + ai * HALF + m * 16) * 1024 + col0;
#pragma unroll
                for (int bj = 0; bj < 2; ++bj)
#pragma unroll
                    for (int n = 0; n < 2; ++n) {
                        const size_t o = off + bj * HALF + n * 16;
                        const f32x4 b = *(const f32x4*)(base + o);
                        f32x4 v = b * alpha + acc[ai][bj][m][n] * s;
                        if (add) { const u32x2 a = *(const u32x2*)(add + o); v[0] += bf_lo(a.x); v[1] += bf_hi(a.x); v[2] += bf_lo(a.y); v[3] += bf_hi(a.y); }
                        *(f32x4*)(out + o) = v;
                    }
            }
    }
};
struct EpiSplit {
    static constexpr bool PERM = true, AFTER_DRAIN = false;
    unsigned char* ar; int mode; const float* tbias;
    __device__ __forceinline__ void operator()(const f32x4 (&acc)[2][2][4][2], const Unit& u, int wr, int wc, int fr, int fq) const {
        EPI_IDS();
        const int pn = u.pn; const int row0 = u.pm * BM + wr * 64 + fr;
        const int tail_tile = (mode == 0) ? 12 : (mode == 2 ? 8 : -1);
        if (pn == tail_tile) {
            float* tail = (float*)(ar + ((mode == 0) ? (size_t)192 << 20 : (size_t)474 << 20));
            if (wc == 0 && fq < 2) {
#pragma unroll
                for (int ai = 0; ai < 2; ++ai)
#pragma unroll
                    for (int m = 0; m < 4; ++m)
#pragma unroll
                        for (int n = 0; n < 2; ++n) {
                            f32x4 v = acc[ai][0][m][n]; const int c = 8 * fq + 4 * n;
                            if (mode == 2) {
#pragma unroll
                                for (int j = 0; j < 4; ++j) v[j] = flogsig(v[j] + tbias[c + j]);
                            }
                            *(f32x4*)(tail + (size_t)(row0 + ai * HALF + m * 16) * 16 + c) = v;
                        }
            }
            return;
        }
        size_t boff; int ld, tb; float sc = 1.f;
        if (mode == 0) { if (pn < 2) { boff = 0; ld = 512; tb = 0; sc = 0.08838834764831845f; } else if (pn < 4) { boff = (size_t)32 << 20; ld = 512; tb = 2; } else if (pn < 8) { boff = (size_t)64 << 20; ld = 1024; tb = 4; } else { boff = (size_t)128 << 20; ld = 1024; tb = 8; } }
        else if (mode == 1) { boff = (size_t)280 << 20; ld = 1024; tb = 0; }
        else if (mode == 2) { if (pn < 4) { boff = (size_t)344 << 20; tb = 0; } else { boff = (size_t)408 << 20; tb = 4; } ld = 1024; }
        else { if (pn < 4) { boff = 0; tb = 0; sc = 0.125f * 1.4426950408889634f; } else { boff = (size_t)64 << 20; tb = 4; } ld = 1024; }
        bf16_t* base = (bf16_t*)(ar + boff);
        const int col0 = (pn - tb) * BM + wc * 32 + 8 * fq;
#pragma unroll
        for (int ai = 0; ai < 2; ++ai)
#pragma unroll
            for (int m = 0; m < 4; ++m) {
                bf16_t* rowp = base + (size_t)(row0 + ai * HALF + m * 16) * ld + col0;
#pragma unroll
                for (int bj = 0; bj < 2; ++bj) {
                    const f32x4 v0 = acc[ai][bj][m][0] * sc, v1 = acc[ai][bj][m][1] * sc;
                    u32x4 w; w.x = cvt_pk_bf16(v0[0], v0[1]); w.y = cvt_pk_bf16(v0[2], v0[3]); w.z = cvt_pk_bf16(v1[0], v1[1]); w.w = cvt_pk_bf16(v1[2], v1[3]);
                    *(u32x4*)(rowp + bj * HALF) = w;
                }
            }
    }
};
struct EpiPle {
    static constexpr bool PERM = true, AFTER_DRAIN = false;
    bf16_t* P;
    __device__ __forceinline__ void operator()(const f32x4 (&acc)[2][2][4][2], const Unit& u, int wr, int wc, int fr, int fq) const {
        EPI_IDS();
        const int row0 = u.pm * BM + wr * 64 + fr, col0 = u.pn * BM + wc * 32 + 8 * fq;
#pragma unroll
        for (int ai = 0; ai < 2; ++ai)
#pragma unroll
            for (int m = 0; m < 4; ++m) {
                bf16_t* rowp = P + (size_t)(row0 + ai * HALF + m * 16) * 1024 + col0;
#pragma unroll
                for (int bj = 0; bj < 2; ++bj) {
                    const u32x4 pv = *(const u32x4*)(rowp + bj * HALF);
                    const f32x4 v0 = acc[ai][bj][m][0], v1 = acc[ai][bj][m][1];
                    u32x4 w;
                    w.x = cvt_pk_bf16(fsigmoid(v0[0]) * bf_lo(pv.x), fsigmoid(v0[1]) * bf_hi(pv.x));
                    w.y = cvt_pk_bf16(fsigmoid(v0[2]) * bf_lo(pv.y), fsigmoid(v0[3]) * bf_hi(pv.y));
                    w.z = cvt_pk_bf16(fsigmoid(v1[0]) * bf_lo(pv.z), fsigmoid(v1[1]) * bf_hi(pv.z));
                    w.w = cvt_pk_bf16(fsigmoid(v1[2]) * bf_lo(pv.w), fsigmoid(v1[3]) * bf_hi(pv.w));
                    *(u32x4*)(rowp + bj * HALF) = w;
                }
            }
    }
};

template <class Epi, class Sched, bool ALIGN_EPI = false, bool SP2 = false>
__device__ __forceinline__ void gemm_phase(PG8_LAS unsigned char* lds, const Gemm g, const Sched& S, const Epi& E) {
    int tid = threadIdx.x; asm volatile("" : "+v"(tid)); const int wid = __builtin_amdgcn_readfirstlane(tid >> 6), lane = tid & 63, wr = wid >> 2, wc = wid & 3, fr = lane & 15, fq = lane >> 4;
    const int K = g.K, nt = K / BK;
    unsigned voffA[2], voffB[2];
#pragma unroll
    for (int i = 0; i < 2; ++i) { int R, C; stage_rc(tid * 16 + i * 8192, R, C); const int Rb = Epi::PERM ? ((R & ~31) + perm32(R & 31)) : R;
        voffA[i] = (unsigned)(R * K + C) * 2u; voffB[i] = (unsigned)(Rb * K + C) * 2u; }
    const size_t kstep = (size_t)(BK * 2);
    const size_t hstep = (size_t)HALF * K * 2;
    const size_t tstep = 2 * hstep;
    const unsigned ldsw = (unsigned)wid * 1024u;
    const int aoff = lds_byte(wr * 64 + fr, fq * 8), boff = lds_byte(wc * 32 + fr, fq * 8);
#define PG8_SA(b, h) (((b) * 2 + (h)) * HTB)
#define PG8_SB(b, h) ((4 + (b) * 2 + (h)) * HTB)
#define PG8_STAGE(bufoff, gbase, voff) do { _Pragma("unroll") for (int _i = 0; _i < 2; ++_i) \
        __builtin_amdgcn_global_load_lds((const unsigned*)((const char*)(gbase) + (voff)[_i]), (PG8_LAS unsigned*)(lds + (bufoff) + ldsw + _i * 8192), 16, 0, 0); } while (0)
#define PG8_LDA(dst, b, h) do { _Pragma("unroll") for (int m = 0; m < 4; ++m) _Pragma("unroll") for (int k = 0; k < 2; ++k) dst[m][k] = *(const PG8_LAS bf16x8*)(lds + PG8_SA(b, h) + aoff + m * 2048 + k * 1024); } while (0)
#define PG8_LDB(dst, b, h) do { _Pragma("unroll") for (int n = 0; n < 2; ++n) _Pragma("unroll") for (int k = 0; k < 2; ++k) dst[n][k] = *(const PG8_LAS bf16x8*)(lds + PG8_SB(b, h) + boff + n * 2048 + k * 1024); } while (0)
#define PG8_MMA(ai, bj, At, Bt) do { __builtin_amdgcn_s_setprio(1); _Pragma("unroll") for (int m = 0; m < 4; ++m) _Pragma("unroll") for (int n = 0; n < 2; ++n) _Pragma("unroll") for (int k = 0; k < 2; ++k) \
        acc[ai][bj][m][n] = __builtin_amdgcn_mfma_f32_16x16x32_bf16(Bt[n][k], At[m][k], acc[ai][bj][m][n], 0, 0, 0); __builtin_amdgcn_s_setprio(0); } while (0)
#define PG8_WAIT_V(n) asm volatile("s_waitcnt vmcnt(" #n ")" ::: "memory")
#define PG8_WAIT_L(n) asm volatile("s_waitcnt lgkmcnt(" #n ")" ::: "memory")
#define PG8_BAR __builtin_amdgcn_s_barrier()
#define PG8_SCHED __builtin_amdgcn_sched_barrier(0)
    Unit cur, nxt; int ui = 0;
    if (!S.next(0, cur)) return;
    f32x4 acc[2][2][4][2];
#pragma unroll
    for (int a = 0; a < 2; ++a)
#pragma unroll
        for (int b = 0; b < 2; ++b)
#pragma unroll
            for (int m = 0; m < 4; ++m)
#pragma unroll
                for (int n = 0; n < 2; ++n) acc[a][b][m][n] = (f32x4){0.f, 0.f, 0.f, 0.f};
    bf16x8 At[4][2], B0[2][2], B1[2][2];
    const char* cA = (const char*)g.A + (size_t)cur.pm * tstep; const char* cB = (const char*)g.Bt + (size_t)cur.pn * tstep;
    S.a_ready(cur);
    if constexpr (SP2) {
        PG8_STAGE(PG8_SB(0, 0), cB, voffB); PG8_STAGE(PG8_SB(0, 1), cB + hstep, voffB); PG8_STAGE(PG8_SA(0, 0), cA, voffA); PG8_STAGE(PG8_SA(0, 1), cA + hstep, voffA);
        if (wr == 1) PG8_BAR;
        PG8_WAIT_V(2); PG8_BAR;
        PG8_STAGE(PG8_SB(1, 0), cB + kstep, voffB); PG8_STAGE(PG8_SA(1, 0), cA + kstep, voffA); PG8_STAGE(PG8_SB(1, 1), cB + hstep + kstep, voffB);
        PG8_WAIT_V(6); PG8_BAR;
    } else {
        PG8_STAGE(PG8_SB(0, 0), cB, voffB); PG8_STAGE(PG8_SA(0, 0), cA, voffA); PG8_STAGE(PG8_SB(0, 1), cB + hstep, voffB); PG8_STAGE(PG8_SA(0, 1), cA + hstep, voffA);
        if (wr == 1) PG8_BAR;
        PG8_WAIT_V(4); PG8_BAR;
        PG8_STAGE(PG8_SB(1, 0), cB + kstep, voffB); PG8_STAGE(PG8_SA(1, 0), cA + kstep, voffA); PG8_STAGE(PG8_SB(1, 1), cB + hstep + kstep, voffB);
        PG8_WAIT_V(6); PG8_BAR;
    }
    for (;;) {
        const bool has_next = S.next(ui + 1, nxt);
        const char* nA = has_next ? (const char*)g.A + (size_t)nxt.pm * tstep : cA; const char* nB = has_next ? (const char*)g.Bt + (size_t)nxt.pn * tstep : cB;
        for (int t = 0; t < nt; t += 2) {
            const bool last = (t == nt - 2);
            const char* a1 = cA + (size_t)(t + 1) * kstep;
            const char* a2 = last ? nA : cA + (size_t)(t + 2) * kstep; const char* b2 = last ? nB : cB + (size_t)(t + 2) * kstep;
            const char* a3 = a2 + kstep; const char* b3 = b2 + kstep;
            if (last && has_next) S.a_ready(nxt);
            if constexpr (SP2) {
            PG8_LDB(B0, 0, 0); PG8_LDB(B1, 0, 1); PG8_SCHED; PG8_LDA(At, 0, 0); PG8_STAGE(PG8_SA(1, 1), a1 + hstep, voffA);
            PG8_WAIT_V(8); PG8_WAIT_L(0); PG8_BAR; PG8_MMA(0, 0, At, B0); PG8_MMA(0, 1, At, B1); PG8_BAR; PG8_SCHED;
            PG8_LDA(At, 0, 1); PG8_STAGE(PG8_SB(0, 0), b2, voffB); PG8_STAGE(PG8_SB(0, 1), b2 + hstep, voffB); PG8_STAGE(PG8_SA(0, 0), a2, voffA);
            PG8_WAIT_V(8); PG8_WAIT_L(0); PG8_BAR; PG8_MMA(1, 0, At, B0); PG8_MMA(1, 1, At, B1); PG8_BAR; PG8_SCHED;
            PG8_LDB(B0, 1, 0); PG8_LDB(B1, 1, 1); PG8_SCHED; PG8_LDA(At, 1, 0); PG8_STAGE(PG8_SA(0, 1), a2 + hstep, voffA);
            PG8_WAIT_V(8); PG8_WAIT_L(0); PG8_BAR; PG8_MMA(0, 0, At, B0); PG8_MMA(0, 1, At, B1); PG8_BAR; PG8_SCHED;
            PG8_LDA(At, 1, 1); PG8_STAGE(PG8_SB(1, 0), b3, voffB); PG8_STAGE(PG8_SB(1, 1), b3 + hstep, voffB); PG8_STAGE(PG8_SA(1, 0), a3, voffA);
            PG8_WAIT_V(8); PG8_WAIT_L(0); PG8_BAR; PG8_MMA(1, 0, At, B0); PG8_MMA(1, 1, At, B1); PG8_BAR; PG8_SCHED;
            } else {
            PG8_LDB(B0, 0, 0); PG8_SCHED; PG8_LDA(At, 0, 0); PG8_STAGE(PG8_SA(1, 1), a1 + hstep, voffA);
            PG8_WAIT_L(8); PG8_BAR; PG8_WAIT_L(0); PG8_MMA(0, 0, At, B0); PG8_BAR; PG8_SCHED;
            PG8_LDB(B1, 0, 1); PG8_STAGE(PG8_SB(0, 0), b2, voffB);
            PG8_BAR; PG8_WAIT_L(0); PG8_MMA(0, 1, At, B1); PG8_BAR;
            PG8_LDA(At, 0, 1); PG8_STAGE(PG8_SA(0, 0), a2, voffA);
            PG8_BAR; PG8_WAIT_L(0); PG8_MMA(1, 0, At, B0); PG8_BAR; PG8_SCHED;
            PG8_STAGE(PG8_SB(0, 1), b2 + hstep, voffB);
            PG8_WAIT_V(6); PG8_BAR; PG8_MMA(1, 1, At, B1); PG8_BAR;
            PG8_LDB(B0, 1, 0); PG8_SCHED; PG8_LDA(At, 1, 0); PG8_STAGE(PG8_SA(0, 1), a2 + hstep, voffA);
            PG8_WAIT_L(8); PG8_BAR; PG8_WAIT_L(0); PG8_MMA(0, 0, At, B0); PG8_BAR; PG8_SCHED;
            PG8_LDB(B1, 1, 1); PG8_STAGE(PG8_SB(1, 0), b3, voffB);
            PG8_BAR; PG8_WAIT_L(0); PG8_MMA(0, 1, At, B1); PG8_BAR;
            PG8_LDA(At, 1, 1); PG8_STAGE(PG8_SA(1, 0), a3, voffA);
            PG8_BAR; PG8_WAIT_L(0); PG8_MMA(1, 0, At, B0); PG8_BAR; PG8_SCHED;
            PG8_STAGE(PG8_SB(1, 1), b3 + hstep, voffB);
            PG8_WAIT_V(6); PG8_BAR; PG8_MMA(1, 1, At, B1); PG8_BAR;
            }
        }
        if constexpr (ALIGN_EPI) { if (wr == 0) PG8_BAR; }
        if constexpr (!Epi::AFTER_DRAIN) { E(acc, cur, wr, wc, fr, fq); S.done(cur); }
        if (!has_next) break;
#pragma unroll
        for (int a = 0; a < 2; ++a)
#pragma unroll
            for (int b = 0; b < 2; ++b)
#pragma unroll
                for (int m = 0; m < 4; ++m)
#pragma unroll
                    for (int n = 0; n < 2; ++n) acc[a][b][m][n] = (f32x4){0.f, 0.f, 0.f, 0.f};
        cur = nxt; cA = nA; cB = nB; ++ui;
        if constexpr (ALIGN_EPI) { if (wr == 1) PG8_BAR; }
    }
    PG8_WAIT_V(0);
    if constexpr (!ALIGN_EPI) { if (wr == 0) PG8_BAR; }
    PG8_BAR;
    if constexpr (Epi::AFTER_DRAIN) { E.fused(acc, cur, wr, wc, fr, fq, lds, wid, lane); S.done(cur); }
#undef PG8_SA
#undef PG8_SB
#undef PG8_STAGE
#undef PG8_LDA
#undef PG8_LDB
#undef PG8_MMA
#undef PG8_WAIT_V
#undef PG8_WAIT_L
#undef PG8_BAR
#undef PG8_SCHED
}
}
#include <hip/hip_bf16.h>
#include <cmath>
namespace attn_body {
using bf16=__hip_bfloat16;
using bf16x8=__attribute__((ext_vector_type(8)))short;
using s16x4=__attribute__((ext_vector_type(4)))short;
using f32x16=__attribute__((ext_vector_type(16)))float;
using u32x4=__attribute__((ext_vector_type(4)))unsigned;
constexpr int BATCH=2,NHEAD=16,SEQ=16384,D=64,DM=NHEAD*D;
constexpr int NW=8,QBLK=32,QB=QBLK*NW,KVBLK=64,NQB=SEQ/QB;
constexpr int ATTN_PITCH=DM, ATTN_UNIT_ROWS=QB;
__device__ __forceinline__ int crow(int r,int hi){return (r&3)+8*(r>>2)+4*hi;}
#define SBAR() __builtin_amdgcn_sched_barrier(0)
__device__ __forceinline__ void cmask(f32x16&p0,f32x16&p1,int jb,int qrel,int hi){
  const float NEG=-INFINITY; int kb=64*jb+4*hi;
  #pragma unroll
  for(int r=0;r<16;++r){int kv=kb+(r&3)+8*(r>>2); if(kv>qrel)p0[r]=NEG; if(kv+32>qrel)p1[r]=NEG;}
}

constexpr int NSLOT=3, SLOTB=8192;
constexpr int LDS_K=0, LDS_V=NSLOT*SLOTB, LDS_WS=2*NSLOT*SLOTB, LDS_OST=LDS_WS+NW*64*4, LDS_BETA=LDS_OST+NW*4096, LDS_BYTES=LDS_BETA+SEQ*4;
constexpr float C2=0.125f*1.4426950408889634f;
__device__ __forceinline__ void glds16(const void*gsrc,unsigned lds_dst){unsigned keep;
  asm volatile("s_mov_b32 %0, m0\n\ts_mov_b32 m0, %2\n\ts_nop 0\n\tglobal_load_lds_dwordx4 %1, off\n\ts_mov_b32 m0, %0":"=&s"(keep):"v"(gsrc),"s"(lds_dst):"memory");}
__device__ __forceinline__ float max3f(float a,float b,float c){float r;asm("v_max3_f32 %0, %1, %2, %3":"=v"(r):"v"(a),"v"(b),"v"(c));return r;}
__device__ __forceinline__ float max2f(float a,float b){float r;asm("v_max_f32_e32 %0, %1, %2":"=v"(r):"v"(a),"v"(b));return r;}
__device__ __forceinline__ float fadd_s(float a,float b){float r;asm("v_add_f32_e32 %0, %1, %2":"=v"(r):"v"(a),"v"(b));return r;}
__device__ __forceinline__ float fsub_s(float a,float b){float r;asm("v_sub_f32_e32 %0, %1, %2":"=v"(r):"v"(a),"v"(b));return r;}
typedef float f32x4_t __attribute__((ext_vector_type(4))); typedef float f32x2_t __attribute__((ext_vector_type(2))); typedef __bf16 bf16x2_t __attribute__((ext_vector_type(2)));
__device__ __forceinline__ unsigned cvtpk_s(float lo,float hi){f32x2_t v={lo,hi};bf16x2_t b=__builtin_convertvector(v,bf16x2_t);return __builtin_bit_cast(unsigned,b);}
#define WAIT_BAR(N) asm volatile("s_waitcnt vmcnt(" #N ") lgkmcnt(0)\n\ts_barrier":::"memory")

__device__ __forceinline__ void qkt(f32x16&p0,f32x16&p1,const char*Kslot,const bf16x8*qr,const f32x16&negm,int r32,int hi){
  const char*kb=Kslot+hi*1024+r32*16;
  #pragma unroll
  for(int d0=0;d0<4;++d0){
    const bf16x8 b0=*reinterpret_cast<const bf16x8*>(kb+d0*2048);
    const bf16x8 b1=*reinterpret_cast<const bf16x8*>(kb+d0*2048+512);
    if(d0==0){p0=__builtin_amdgcn_mfma_f32_32x32x16_bf16(b0,qr[0],negm,0,0,0);p1=__builtin_amdgcn_mfma_f32_32x32x16_bf16(b1,qr[0],negm,0,0,0);}
    else{p0=__builtin_amdgcn_mfma_f32_32x32x16_bf16(b0,qr[d0],p0,0,0,0);p1=__builtin_amdgcn_mfma_f32_32x32x16_bf16(b1,qr[d0],p1,0,0,0);}}
}
typedef __attribute__((address_space(3))) const char* lds_cptr;
typedef short v4i16_t __attribute__((ext_vector_type(4)));
__device__ __forceinline__ void kload8(bf16x8*kf,lds_cptr kp){
  kf[0]=*(const __attribute__((address_space(3))) bf16x8*)(kp);      kf[1]=*(const __attribute__((address_space(3))) bf16x8*)(kp+512);
  kf[2]=*(const __attribute__((address_space(3))) bf16x8*)(kp+2048); kf[3]=*(const __attribute__((address_space(3))) bf16x8*)(kp+2560);
  kf[4]=*(const __attribute__((address_space(3))) bf16x8*)(kp+4096); kf[5]=*(const __attribute__((address_space(3))) bf16x8*)(kp+4608);
  kf[6]=*(const __attribute__((address_space(3))) bf16x8*)(kp+6144); kf[7]=*(const __attribute__((address_space(3))) bf16x8*)(kp+6656);
}
__device__ __forceinline__ void kload2(bf16x8*kf,lds_cptr kp,int j){ kf[2*j]=*(const __attribute__((address_space(3))) bf16x8*)(kp+j*2048); kf[2*j+1]=*(const __attribute__((address_space(3))) bf16x8*)(kp+j*2048+512); }
__device__ __forceinline__ s16x4 vtr(lds_cptr p){ return __builtin_bit_cast(s16x4,__builtin_amdgcn_ds_read_tr16_b64_v4i16((__attribute__((address_space(3))) v4i16_t*)p)); }
__device__ __forceinline__ float rowmax(const f32x16&p0,const f32x16&p1){
  float a=max3f(p0[0],p0[1],p1[0]),b=max3f(p0[2],p0[3],p1[1]);a=max3f(a,p1[2],p1[3]);
  #pragma unroll
  for(int r=4;r<16;r+=4){a=max3f(a,p0[r],p0[r+1]);b=max3f(b,p0[r+2],p0[r+3]);a=max3f(a,p1[r],p1[r+1]);b=max3f(b,p1[r+2],p1[r+3]);}
  const float m=max2f(a,b);
  auto rr=__builtin_amdgcn_permlane32_swap(__float_as_uint(m),__float_as_uint(m),false,false);
  return max2f(__uint_as_float(rr[0]),__uint_as_float(rr[1]));
}
__device__ __forceinline__ void pv(f32x16*o,int vb,bf16x8 pa0,bf16x8 pa1,bf16x8 pa2,bf16x8 pa3){
  #pragma unroll
  for(int d0=0;d0<2;++d0){s16x4 lo[4],hi[4];
    #pragma unroll
    for(int ks=0;ks<4;++ks){
      asm volatile("ds_read_b64_tr_b16 %0,%1 offset:%c2":"=&v"(lo[ks]):"v"(vb),"i"(d0*4096+ks*1024):"memory");
      asm volatile("ds_read_b64_tr_b16 %0,%1 offset:%c2":"=&v"(hi[ks]):"v"(vb),"i"(d0*4096+ks*1024+512):"memory");}
    asm volatile("s_waitcnt lgkmcnt(0)":::"memory");SBAR();
    #define PK(k) (bf16x8){lo[k][0],lo[k][1],lo[k][2],lo[k][3],hi[k][0],hi[k][1],hi[k][2],hi[k][3]}
    o[d0]=__builtin_amdgcn_mfma_f32_32x32x16_bf16(pa0,PK(0),o[d0],0,0,0);
    o[d0]=__builtin_amdgcn_mfma_f32_32x32x16_bf16(pa1,PK(1),o[d0],0,0,0);
    o[d0]=__builtin_amdgcn_mfma_f32_32x32x16_bf16(pa2,PK(2),o[d0],0,0,0);
    o[d0]=__builtin_amdgcn_mfma_f32_32x32x16_bf16(pa3,PK(3),o[d0],0,0,0);
    #undef PK
  }
}

#ifndef ATTN_STORE16
#define ATTN_STORE16(p,v) (*(u32x4*)(p)=(v))
#endif
template<int THRL> __device__ __forceinline__ void attn_unit(int b,int h,int qb,const bf16*Q,const bf16*__restrict__ K,const bf16*__restrict__ V,bf16*O,const bf16*__restrict__ Gt,const float*__restrict__ cs,char*shm){
  int tid=threadIdx.x; asm volatile("":"+v"(tid)); const int lane=tid&63,r32=lane&31,hi=lane>>5; const int wid=__builtin_amdgcn_readfirstlane(tid>>6);
  const long rowbase=(long)b*SEQ; const int q0=qb*QB;
  const bf16*Qw=Q+(rowbase+q0+wid*QBLK)*DM+h*D;
  const bf16*Kh=K+rowbase*DM+h*D,*Vh=V+rowbase*DM+h*D;
  const unsigned lds0=(unsigned)(uintptr_t)shm;
  float*wsf=(float*)(shm+LDS_WS)+wid*64;
  const bf16*ksrc=Kh+(long)lane*DM+wid*8;
  const bf16*vsrc=Vh+(long)(16*(wid&3)+(lane>>2))*DM+(wid>>2)*32+(lane&3)*8;
  const unsigned kdst=lds0+LDS_K+wid*1024, vdst=lds0+LDS_V+wid*1024;
  #define DMA_K(t,slot) glds16(ksrc+(long)(t)*KVBLK*DM,(unsigned)__builtin_amdgcn_readfirstlane(kdst+(slot)))
  #define DMA_V(t,slot) glds16(vsrc+(long)(t)*KVBLK*DM,(unsigned)__builtin_amdgcn_readfirstlane(vdst+(slot)))
  const int vb0=(int)(lds0+LDS_V)+((lane>>4)&1)*32+(lane&3)*8+(4*hi+((lane&15)>>2))*64;
  const char*Kbase=shm+LDS_K; bf16x8 kf[8];
  const lds_cptr shm3=(lds_cptr)shm; const lds_cptr kp0=shm3+LDS_K+hi*1024+r32*16; const lds_cptr vp0=shm3+LDS_V+((lane>>4)&1)*32+(lane&3)*8+(4*hi+((lane&15)>>2))*64;
  const int NT=(q0+QB)/KVBLK;
  {
    typedef __attribute__((address_space(3))) float* lds_fptr; lds_fptr bt=(lds_fptr)((lds_cptr)shm+LDS_BETA);
    const float cref=cs[q0]; const int nkv=NT*KVBLK;
    for(int s_=tid;s_<nkv;s_+=NW*64) bt[s_]=(cref-cs[s_])*1.4426950408889634f;
  }
  const lds_cptr bp0=(lds_cptr)shm+LDS_BETA+hi*16;
  #define LDB(P0,P1,t) do{ const lds_cptr bq_=bp0+(t)*256; _Pragma("unroll") for(int g_=0;g_<4;++g_){ \
      const f32x4_t u0_=*(const __attribute__((address_space(3))) f32x4_t*)(bq_+g_*32), u1_=*(const __attribute__((address_space(3))) f32x4_t*)(bq_+128+g_*32); \
      P0[4*g_]=u0_[0];P0[4*g_+1]=u0_[1];P0[4*g_+2]=u0_[2];P0[4*g_+3]=u0_[3]; P1[4*g_]=u1_[0];P1[4*g_+1]=u1_[1];P1[4*g_+2]=u1_[2];P1[4*g_+3]=u1_[3]; } }while(0)
  DMA_K(0,0);DMA_V(0,0);DMA_K(1,SLOTB);
  bf16x8 qr[4];
  #pragma unroll
  for(int d0=0;d0<4;++d0)qr[d0]=*reinterpret_cast<const bf16x8*>(&Qw[(long)r32*DM+d0*16+hi*8]);
  float mhat=0.f,l_reg=0.f;f32x16 o[2];o[0]=f32x16{};o[1]=f32x16{};f32x16 zero16=f32x16{};
  const int qrel=wid*QBLK+r32;
  #define CMASK(P0,P1,t) do{int jb_=(t)-(NT-4); if(jb_>=0)cmask(P0,P1,jb_,qrel,hi);}while(0)
  bool resc=false;
  #define START(P0,P1) do{ const float rm=rowmax(P0,P1); resc=false; \
    { const float dl=rm; mhat=fadd_s(mhat,dl); \
      _Pragma("unroll") for(int r=0;r<16;++r){P0[r]=fsub_s(P0[r],dl);P1[r]=fsub_s(P1[r],dl);} } \
    _Pragma("unroll") for(int r=0;r<16;++r)P0[r]=__builtin_amdgcn_exp2f(P0[r]); }while(0)
  #define RESC() do{ if(resc){ asm volatile("s_waitcnt lgkmcnt(0)":::"memory"); \
      _Pragma("unroll") for(int d_=0;d_<2;++d_) _Pragma("unroll") for(int r=0;r<16;++r)o[d_][r]*=wsf[crow(r,hi)]; } }while(0)
  f32x16 pA0,pA1,pB0,pB1;
  int sl_prev=0,sl_cur=0,sl_next=SLOTB;
  #define ROT() do{sl_prev=sl_cur;sl_cur=sl_next;sl_next=(sl_next==(NSLOT-1)*SLOTB)?0:sl_next+SLOTB;}while(0)
  DMA_K(2,2*SLOTB);
  WAIT_BAR(3);
  qkt(pA0,pA1,Kbase,qr,zero16,r32,hi);asm volatile("s_nop 15\n\ts_nop 7":"+v"(pA0),"+v"(pA1));
  { LDB(pB0,pB1,0); _Pragma("unroll") for(int r=0;r<16;++r){pA0[r]+=pB0[r];pA1[r]+=pB1[r];} }
  CMASK(pA0,pA1,0);
  START(pA0,pA1);
  _Pragma("unroll") for(int r=0;r<16;++r)pA1[r]=__builtin_amdgcn_exp2f(pA1[r]);
  LDB(pB0,pB1,1);
  WAIT_BAR(0);
  DMA_K(3,0);DMA_V(1,SLOTB);
  ROT();
  kload8(kf,kp0+sl_cur);
  WAIT_BAR(2);
  s16x4 vlo[8],vhi[8]; u32x4 pw0,pw1,pw2,pw3;
  #define PKW(P,B) cvtpk_s(P[B],P[B+1])
  #define PAF(k) __builtin_bit_cast(bf16x8,pw##k)
  #define VFR(i) (bf16x8){vlo[i][0],vlo[i][1],vlo[i][2],vlo[i][3],vhi[i][0],vhi[i][1],vhi[i][2],vhi[i][3]}
  #define PIN(x) asm volatile("":"+v"(x))
  #define MX3(a,b,c) __builtin_fmaxf(__builtin_fmaxf((a),(b)),(c))
  #define GAPA(MF,A0,A1,A2,A3,W0,W1,PW) do{ MF; sacc+=A0; sacc+=A1; sacc+=A2; sacc+=A3; PIN(sacc); W0; W1; PIN(PW); SBAR(); }while(0)
  #define EX(v) __builtin_amdgcn_exp2f(v)
  #define GAPB(MF,X,B) do{ MF; X[B]=EX(X[B]); X[B+1]=EX(X[B+1]); X[B+2]=EX(X[B+2]); X[B+3]=EX(X[B+3]); PIN(X); SBAR(); }while(0)
  #define VRD(i) do{ vlo[i]=vtr(vp_+(((i)>>2)*4096+((i)&3)*1024)); vhi[i]=vtr(vp_+(((i)>>2)*4096+((i)&3)*1024+512)); }while(0)
  #define KRD(G,j) do{ if(G){ kload2(kf,kp0+sl_next,j); SBAR(); } }while(0)
  #define STEP(C0,C1,P0,P1,t,GK,GV,GL) do{ SBAR(); \
    const lds_cptr vp_=vp0+sl_prev; \
    _Pragma("unroll") for(int r=0;r<16;++r){C0[r]-=mhat;C1[r]-=mhat;} \
    VRD(0); SBAR(); float sacc=(P0[0]+P0[1]); \
    GAPA(C0=__builtin_amdgcn_mfma_f32_32x32x16_bf16(kf[0],qr[0],C0,0,0,0), P0[2],P0[3],P0[4],P0[5],     pw0[0]=PKW(P0,0), pw0[1]=PKW(P0,2), pw0); \
    VRD(4); SBAR(); GAPA(C1=__builtin_amdgcn_mfma_f32_32x32x16_bf16(kf[1],qr[0],C1,0,0,0), P0[6],P0[7],P0[8],P0[9],     pw0[2]=PKW(P0,4), pw0[3]=PKW(P0,6), pw0); \
    VRD(1); SBAR(); GAPA(C0=__builtin_amdgcn_mfma_f32_32x32x16_bf16(kf[2],qr[1],C0,0,0,0),   P0[10],P0[11],P0[12],P0[13], pw1[0]=PKW(P0,8), pw1[1]=PKW(P0,10), pw1); \
    VRD(5); SBAR(); GAPA(C1=__builtin_amdgcn_mfma_f32_32x32x16_bf16(kf[3],qr[1],C1,0,0,0),   P0[14],P0[15],P1[0],P1[1],   pw1[2]=PKW(P0,12),pw1[3]=PKW(P0,14), pw1); \
    VRD(2); SBAR(); GAPA(C0=__builtin_amdgcn_mfma_f32_32x32x16_bf16(kf[4],qr[2],C0,0,0,0),   P1[2],P1[3],P1[4],P1[5],     pw2[0]=PKW(P1,0), pw2[1]=PKW(P1,2), pw2); \
    VRD(6); SBAR(); GAPA(C1=__builtin_amdgcn_mfma_f32_32x32x16_bf16(kf[5],qr[2],C1,0,0,0),   P1[6],P1[7],P1[8],P1[9],     pw2[2]=PKW(P1,4), pw2[3]=PKW(P1,6), pw2); \
    VRD(3); SBAR(); GAPA(C0=__builtin_amdgcn_mfma_f32_32x32x16_bf16(kf[6],qr[3],C0,0,0,0),   P1[10],P1[11],P1[12],P1[13], pw3[0]=PKW(P1,8), pw3[1]=PKW(P1,10), pw3); \
    VRD(7); SBAR(); GAPA(C1=__builtin_amdgcn_mfma_f32_32x32x16_bf16(kf[7],qr[3],C1,0,0,0),   P1[14],P1[15],0.f,0.f,       pw3[2]=PKW(P1,12),pw3[3]=PKW(P1,14), pw3); \
    l_reg+=sacc; \
    if(GV){LDB(P0,P1,(t)+1);} \
    if(GK){DMA_K((t)+3,sl_cur);} if(GV){DMA_V((t)+1,sl_next);} \
    CMASK(C0,C1,t); \
    { float a=MX3(C0[0],C0[1],C1[0]),b=MX3(C0[2],C0[3],C1[1]); a=MX3(a,C1[2],C1[3]); \
      _Pragma("unroll") for(int r=4;r<16;r+=4){a=MX3(a,C0[r],C0[r+1]);b=MX3(b,C0[r+2],C0[r+3]);a=MX3(a,C1[r],C1[r+1]);b=MX3(b,C1[r+2],C1[r+3]);} \
      float rm=__builtin_fmaxf(a,b); { auto rr=__builtin_amdgcn_permlane32_swap(__float_as_uint(rm),__float_as_uint(rm),false,false); rm=__builtin_fmaxf(__uint_as_float(rr[0]),__uint_as_float(rr[1])); } \
      resc=false; \
      if(__builtin_expect(__any(rm>(float)THRL),0)){ const float dl=__builtin_fmaxf(rm,0.f); mhat+=dl; \
        _Pragma("unroll") for(int r=0;r<16;++r){C0[r]-=dl;C1[r]-=dl;} \
        const float f=__builtin_amdgcn_exp2f(-dl); l_reg*=f; if(hi==0)wsf[r32]=f; resc=true; } } \
    SBAR(); \
    GAPB(o[0]=__builtin_amdgcn_mfma_f32_32x32x16_bf16(PAF(0),VFR(0),o[0],0,0,0), C0,0); \
    GAPB(o[1]=__builtin_amdgcn_mfma_f32_32x32x16_bf16(PAF(0),VFR(4),o[1],0,0,0), C0,4); \
    KRD(GL,0); GAPB(o[0]=__builtin_amdgcn_mfma_f32_32x32x16_bf16(PAF(1),VFR(1),o[0],0,0,0), C0,8); \
    KRD(GL,1); GAPB(o[1]=__builtin_amdgcn_mfma_f32_32x32x16_bf16(PAF(1),VFR(5),o[1],0,0,0), C0,12); \
    KRD(GL,2); GAPB(o[0]=__builtin_amdgcn_mfma_f32_32x32x16_bf16(PAF(2),VFR(2),o[0],0,0,0), C1,0); \
    KRD(GL,3); GAPB(o[1]=__builtin_amdgcn_mfma_f32_32x32x16_bf16(PAF(2),VFR(6),o[1],0,0,0), C1,4); \
    GAPB(o[0]=__builtin_amdgcn_mfma_f32_32x32x16_bf16(PAF(3),VFR(3),o[0],0,0,0), C1,8); \
    GAPB(o[1]=__builtin_amdgcn_mfma_f32_32x32x16_bf16(PAF(3),VFR(7),o[1],0,0,0), C1,12); \
    }while(0)
  int t=1;
  #undef CMASK
  #define CMASK(P0,P1,t) do{}while(0)
  for(;t+5<NT;t+=2){
    STEP(pB0,pB1,pA0,pA1,t,true,true,true);     WAIT_BAR(2); RESC(); ROT();
    STEP(pA0,pA1,pB0,pB1,t+1,true,true,true);   WAIT_BAR(2); RESC(); ROT();
  }
  #undef CMASK
  #define CMASK(P0,P1,t) do{int jb_=(t)-(NT-4); if(jb_>=0)cmask(P0,P1,jb_,qrel,hi);}while(0)
  #define ENDW(tt) do{ if((tt)+3<NT){WAIT_BAR(2);} else if((tt)+2<NT){WAIT_BAR(1);} else {WAIT_BAR(0);} }while(0)
  for(;t+1<NT;t+=2){
    STEP(pB0,pB1,pA0,pA1,t,(t+3<NT),(t+1<NT),(t+1<NT));       ENDW(t);   RESC(); ROT();
    STEP(pA0,pA1,pB0,pB1,t+1,(t+4<NT),(t+2<NT),(t+2<NT));     ENDW(t+1); RESC(); ROT();
  }
  STEP(pB0,pB1,pA0,pA1,NT-1,false,false,false); RESC();
  { float sacc=pB0[0]+pB0[1]; _Pragma("unroll") for(int r=2;r<16;++r)sacc+=pB0[r]; _Pragma("unroll") for(int r=0;r<16;++r)sacc+=pB1[r]; l_reg+=sacc;
    pw0=(u32x4){PKW(pB0,0),PKW(pB0,2),PKW(pB0,4),PKW(pB0,6)};pw1=(u32x4){PKW(pB0,8),PKW(pB0,10),PKW(pB0,12),PKW(pB0,14)};pw2=(u32x4){PKW(pB1,0),PKW(pB1,2),PKW(pB1,4),PKW(pB1,6)};pw3=(u32x4){PKW(pB1,8),PKW(pB1,10),PKW(pB1,12),PKW(pB1,14)};
    SBAR(); pv(o,vb0+sl_cur,PAF(0),PAF(1),PAF(2),PAF(3)); }
  #undef PKW
  #undef PAF
  #undef VFR
  #undef PIN
  #undef MX3
  #undef GAPA
  #undef GAPB
  #undef EX
  #undef VRD
  #undef KRD
  #undef STEP
  #undef ENDW
  {auto rr=__builtin_amdgcn_permlane32_swap(__float_as_uint(l_reg),__float_as_uint(l_reg),false,false);l_reg=__uint_as_float(rr[0])+__uint_as_float(rr[1]);}
  if(hi==0)wsf[32+r32]=l_reg;asm volatile("s_waitcnt lgkmcnt(0)":::"memory");
  float rli[16];
  #pragma unroll
  for(int r=0;r<16;++r)rli[r]=__builtin_amdgcn_rcpf(wsf[32+crow(r,hi)]);
  bf16*Ow=O+(rowbase+q0+wid*QBLK)*DM+h*D;
  { bf16*stg=(bf16*)(shm+LDS_OST)+wid*2048;
    #pragma unroll
    for(int r=0;r<16;++r){const int orow=crow(r,hi);
      #pragma unroll
      for(int d0=0;d0<2;++d0)stg[orow*64+d0*32+r32]=__float2bfloat16(o[d0][r]*rli[r]);}
    asm volatile("s_waitcnt lgkmcnt(0)":::"memory");
    const bf16*Gw=Gt+(rowbase+q0+wid*QBLK)*DM+h*D;
    #pragma unroll
    for(int i=0;i<4;++i){const int row=i*8+(lane>>3),ch=lane&7; u32x4 v=*(const u32x4*)(stg+row*64+ch*8); const u32x4 gq=*(const u32x4*)(Gw+(long)row*DM+ch*8);
      #pragma unroll
      for(int e=0;e<4;++e){ const float o0=__uint_as_float(v[e]<<16),o1=__uint_as_float(v[e]&0xffff0000u),g0=__uint_as_float(gq[e]<<16),g1=__uint_as_float(gq[e]&0xffff0000u);
        const float s0=__builtin_amdgcn_rcpf(1.f+__builtin_amdgcn_exp2f(-1.4426950408889634f*g0)),s1=__builtin_amdgcn_rcpf(1.f+__builtin_amdgcn_exp2f(-1.4426950408889634f*g1));
        v[e]=cvtpk_s(o0*s0,o1*s1); }
      ATTN_STORE16(Ow+(long)row*DM+ch*8,v);} }
  asm volatile("s_waitcnt lgkmcnt(0)\n\ts_barrier":::"memory");
  #undef DMA_K
  #undef DMA_V
  #undef LDB
  #undef CMASK
  #undef START
  #undef RESC
  #undef ROT
}
constexpr int ATTN_LDS_BYTES=LDS_BYTES;
struct AttnTensors { const bf16* Q; const bf16* K; const bf16* V; bf16* O; const bf16* G; const float* C; };
struct AttnUnit { int bh; int qb; };
struct StaticOrder {
  int vcu,G;
  __device__ __forceinline__ explicit StaticOrder(int grid,int block):vcu((grid%8==0)?(block%8)*(grid/8)+block/8:block),G(grid){}
  __device__ __forceinline__ bool next(int i,AttnUnit&u)const{
    if(G==256){ if(i>=8)return false; const int s=vcu&7; u.bh=vcu>>3; const int qi=i*8+((i&1)?7-s:s); u.qb=NQB-1-qi; return true; }
    const int L=i*G+vcu; if(L>=BATCH*NHEAD*NQB)return false; u.bh=L%(BATCH*NHEAD); u.qb=NQB-1-L/(BATCH*NHEAD); return true; }
  __device__ __forceinline__ void a_ready(const AttnUnit&)const{}
  __device__ __forceinline__ void done(const AttnUnit&)const{}
};
template<class Sched,int THRL=8> __device__ __forceinline__ void attn_phase(char*lds,const AttnTensors&T,const Sched&S){
  AttnUnit u;
  for(int i=0;S.next(i,u);++i){ S.a_ready(u); attn_unit<THRL>(u.bh/NHEAD,u.bh%NHEAD,u.qb,T.Q,T.K,T.V,T.O,T.G,T.C+(long)u.bh*SEQ,lds); S.done(u); }
}
#undef SBAR
#undef WAIT_BAR
}
#ifndef PG8_SP2
#define PG8_SP2 true
#endif
#ifndef PG8_ALIGN
#define PG8_ALIGN true
#endif
constexpr int NWAVES = 8;
constexpr int SEQL = 16384, NB = 2, M = NB * SEQL, D = 1024, FF = 2816, PLE = 256, DEPTH = 4;
constexpr int GLA_IN = 3088, GLA_INP = 3328, KVF_N = 2064, KVF_NP = 2304;
constexpr int NCH = SEQL / 64;
constexpr float LN_EPS = 1e-5f;
constexpr float DN_ALPHA = 1.681792830507429f;
constexpr size_t MiB = 1u << 20;
constexpr size_t WS_W = 1 * MiB, WS_XB = 50 * MiB, WS_AR = 114 * MiB, WS_END = (114 + 476) * MiB;
constexpr size_t OW_F1IN = 0, OW_F1OUT = 5767168, OW_F2IN = 8650752, OW_F2OUT = 14417920, OW_PG = 17301504, OW_PP = 18350080, OW_MIXIN = 18612224, OW_MIXO = 22020096, OW_KVF = 23068672;
constexpr size_t AR_H = 0, AR_PB = 176 * MiB, AR_PLE = 280 * MiB, AR_KSH = 344 * MiB, AR_VSH = 408 * MiB, AR_CSH = 472 * MiB, AR_FLOG = 474 * MiB;
constexpr size_t AR_GQ = 0, AR_GK = 32 * MiB, AR_GV = 64 * MiB, AR_GR = 128 * MiB, AR_GA = 192 * MiB, AR_GD = 194 * MiB, AR_GKT = 196 * MiB, AR_GVT = 228 * MiB, AR_GST = 292 * MiB;
constexpr size_t AR_FQ = 0, AR_FG = 64 * MiB;
constexpr int LDS_BYTES = 150016;
static_assert(attn_body::ATTN_LDS_BYTES <= LDS_BYTES && pg8::STAGE_BYTES <= LDS_BYTES, "LDS map");

#define LAS __attribute__((address_space(3)))
typedef unsigned short bf16;
typedef unsigned v4u __attribute__((ext_vector_type(4)));
typedef unsigned v2u __attribute__((ext_vector_type(2)));
typedef float f32x4 __attribute__((ext_vector_type(4)));
typedef float f32x16 __attribute__((ext_vector_type(16)));
typedef short bf16x8 __attribute__((ext_vector_type(8)));
typedef short bf16x4 __attribute__((ext_vector_type(4)));
#define LDS_WAIT() asm volatile("s_waitcnt lgkmcnt(0)" ::: "memory")
__device__ __forceinline__ unsigned pk2(float lo, float hi) { typedef float f2 __attribute__((ext_vector_type(2))); typedef __bf16 b2 __attribute__((ext_vector_type(2))); f2 v = {lo, hi}; b2 b = __builtin_convertvector(v, b2); return __builtin_bit_cast(unsigned, b); }
__device__ __forceinline__ float bflo(unsigned w) { return __uint_as_float(w << 16); }
__device__ __forceinline__ float bfhi(unsigned w) { return __uint_as_float(w & 0xffff0000u); }
__device__ __forceinline__ float wave_sum(float v) {
#pragma unroll
    for (int o = 1; o < 64; o <<= 1) v += __shfl_xor(v, o);
    return v;
}

struct Args { const float* in[24]; float* out; unsigned char* ws; };

struct Frame {
    unsigned char* lds; unsigned char* ws; unsigned char* ar;
    int tid, lane, wave, G, gw, NGW, bx;
};

__device__ __forceinline__ void tr_item(const float* __restrict__ W, int K, int N, int nblk, bf16* __restrict__ WT, int mode, float* scr, int item, int lane) {
    const int kb = item / nblk, nb = item % nblk, k0 = 64 * kb, n0 = 32 * nb;
    const int nn = n0 + (lane & 31); const bool ok = nn < N;
#pragma unroll 8
    for (int i = 0; i < 32; ++i) { const int kk = 2 * i + (lane >> 5); scr[kk * 33 + (lane & 31)] = ok ? W[(size_t)(k0 + kk) * N + nn] : 0.f; }
    LDS_WAIT();
    const int c = lane & 7;
#pragma unroll
    for (int j = 0; j < 4; ++j) { const int n = (lane >> 3) + 8 * j; const float* s = scr + (8 * c) * 33 + n;
        v4u o; o.x = pk2(s[0 * 33], s[1 * 33]); o.y = pk2(s[2 * 33], s[3 * 33]); o.z = pk2(s[4 * 33], s[5 * 33]); o.w = pk2(s[6 * 33], s[7 * 33]);
        const int gn = n0 + n; int drow = gn;
        if (mode) drow = (gn < FF) ? (gn / 128) * 256 + (gn % 128) : ((gn - FF) / 128) * 256 + 128 + ((gn - FF) % 128);
        *(v4u*)(WT + (size_t)drow * K + k0 + 8 * c) = o; }
    LDS_WAIT();
}
__device__ __forceinline__ void convert_weights(const Frame& F, const float* w_f1in, const float* w_f2in, const float* w_f1out, const float* w_f2out, const float* w_pg, const float* w_pp, const float* w_glain, const float* w_foxin, const float* w_glao, const float* w_foxo, const float* w_kvf, int L, bool with_kvf) {
    float* scr = (float*)(F.lds + F.wave * 16384);
    bf16* Wb = (bf16*)(F.ws + WS_W);
    const int I0 = 16 * 176, I1 = 44 * 32, I4 = 16 * 32, I5 = 4 * 32, I6 = (L < 2) ? 16 * (GLA_INP / 32) : 16 * 64, I7 = 16 * 32, I8 = with_kvf ? 16 * (KVF_NP / 32) : 0;
    const int NIT = 2 * I0 + 2 * I1 + I4 + I5 + I6 + I7 + I8;
    for (int it = F.gw; it < NIT; it += F.NGW) {
        int r = it;
        if (r < I0) { tr_item(w_f1in + (size_t)L * D * 2 * FF, D, 2 * FF, 176, Wb + OW_F1IN, 1, scr, r, F.lane); continue; } r -= I0;
        if (r < I0) { tr_item(w_f2in + (size_t)L * D * 2 * FF, D, 2 * FF, 176, Wb + OW_F2IN, 1, scr, r, F.lane); continue; } r -= I0;
        if (r < I1) { tr_item(w_f1out + (size_t)L * FF * D, FF, D, 32, Wb + OW_F1OUT, 0, scr, r, F.lane); continue; } r -= I1;
        if (r < I1) { tr_item(w_f2out + (size_t)L * FF * D, FF, D, 32, Wb + OW_F2OUT, 0, scr, r, F.lane); continue; } r -= I1;
        if (r < I4) { tr_item(w_pg + (size_t)L * D * D, D, D, 32, Wb + OW_PG, 0, scr, r, F.lane); continue; } r -= I4;
        if (r < I5) { tr_item(w_pp + (size_t)L * PLE * D, PLE, D, 32, Wb + OW_PP, 0, scr, r, F.lane); continue; } r -= I5;
        if (r < I6) { if (L < 2) tr_item(w_glain + (size_t)L * D * GLA_IN, D, GLA_IN, GLA_INP / 32, Wb + OW_MIXIN, 0, scr, r, F.lane);
                      else tr_item(w_foxin + (size_t)(L - 2) * D * 2048, D, 2048, 64, Wb + OW_MIXIN, 0, scr, r, F.lane); continue; } r -= I6;
        if (r < I7) { tr_item((L < 2) ? w_glao + (size_t)L * D * D : w_foxo + (size_t)(L - 2) * D * D, D, D, 32, Wb + OW_MIXO, 0, scr, r, F.lane); continue; } r -= I7;
        tr_item(w_kvf, D, KVF_N, KVF_NP / 32, Wb + OW_KVF, 0, scr, r, F.lane);
    }
}
__device__ __forceinline__ void cvt_rows(const Frame& F, const float* __restrict__ src, bf16* __restrict__ dst, size_t n) {
    const size_t nthr = (size_t)F.G * 512, t0 = (size_t)F.bx * 512 + F.tid;
    for (size_t i = t0 * 8; i < n; i += nthr * 8) {
        const f32x4 a = *(const f32x4*)(src + i), b = *(const f32x4*)(src + i + 4);
        v4u o; o.x = pk2(a[0], a[1]); o.y = pk2(a[2], a[3]); o.z = pk2(b[0], b[1]); o.w = pk2(b[2], b[3]);
        *(v4u*)(dst + i) = o;
    }
}
__device__ __forceinline__ void ln_phase(const Frame& F, const float* __restrict__ g, const float* __restrict__ bta, float* X, bf16* XB) {
    f32x4 gv[4], bv[4];
#pragma unroll
    for (int j = 0; j < 4; ++j) { gv[j] = ((const f32x4*)g)[F.lane + 64 * j]; bv[j] = ((const f32x4*)bta)[F.lane + 64 * j]; }
    for (int m = F.gw; m < M; m += F.NGW) {
        f32x4* xr = (f32x4*)(X + (size_t)m * D) + F.lane;
        f32x4 v[4]; float s = 0.f;
#pragma unroll
        for (int j = 0; j < 4; ++j) { v[j] = xr[64 * j]; s += (v[j][0] + v[j][1]) + (v[j][2] + v[j][3]); }
        const float mean = wave_sum(s) * (1.f / D); float s2 = 0.f;
#pragma unroll
        for (int j = 0; j < 4; ++j) { v[j] = v[j] - mean; s2 += (v[j][0] * v[j][0] + v[j][1] * v[j][1]) + (v[j][2] * v[j][2] + v[j][3] * v[j][3]); }
        const float rstd = 1.f / sqrtf(wave_sum(s2) * (1.f / D) + LN_EPS);
        v2u* o8 = (v2u*)(XB + (size_t)m * D) + F.lane;
#pragma unroll
        for (int j = 0; j < 4; ++j) { const f32x4 y = v[j] * rstd * gv[j] + bv[j]; xr[64 * j] = y; v2u w; w.x = pk2(y[0], y[1]); w.y = pk2(y[2], y[3]); o8[64 * j] = w; }
    }
}
__device__ __forceinline__ void cumsum_phase(const Frame& F, const float* __restrict__ flog, float* __restrict__ cs) {
    float* sh = (float*)F.lds;
    for (int u = F.bx; u < NB * 16; u += F.G) {
        const int b = u >> 4, h = u & 15; const float* src = flog + ((size_t)b * SEQL + (size_t)F.tid * 32) * 16 + h;
        float tot = 0.f;
#pragma unroll 8
        for (int i = 0; i < 32; ++i) tot += src[i * 16];
        __syncthreads();
        sh[F.tid] = tot;
        __syncthreads();
        float pre = 0.f;
        for (int i = 0; i < F.tid; ++i) pre += sh[i];
        float* dst = cs + (size_t)u * SEQL + F.tid * 32;
#pragma unroll 8
        for (int i = 0; i < 32; ++i) { pre += src[i * 16]; dst[i] = pre; }
    }
}
__device__ __forceinline__ unsigned f2bf1(float x) { return pk2(x, 0.f) & 0xffffu; }
#define MFMA32(a, b, c) __builtin_amdgcn_mfma_f32_32x32x16_bf16((a), (b), (c), 0, 0, 0)
#define MFMA16(a, b, c) __builtin_amdgcn_mfma_f32_16x16x32_bf16((a), (b), (c), 0, 0, 0)
__device__ __forceinline__ void gla_prep(const Frame& F, const float* __restrict__ wa2, const float* __restrict__ ba) {
    bf16* GQ = (bf16*)(F.ar + AR_GQ); bf16* GK = (bf16*)(F.ar + AR_GK); const bf16* GV = (const bf16*)(F.ar + AR_GV); const float* GA = (const float*)(F.ar + AR_GA);
    float* GD = (float*)(F.ar + AR_GD); bf16* GKT = (bf16*)(F.ar + AR_GKT); bf16* GVT = (bf16*)(F.ar + AR_GVT);
    float* sa = (float*)F.lds; bf16* sv = (bf16*)(F.lds + 4096);
    const int j = F.tid;
    float w[16];
#pragma unroll
    for (int m = 0; m < 16; ++m) w[m] = wa2[m * 512 + j];
    const float bj = ba[j];
    for (int cu = F.bx; cu < NB * NCH; cu += F.G) {
        const size_t m0 = (size_t)cu * 64;
        __syncthreads();
        if (F.tid < 256) ((f32x4*)sa)[F.tid] = ((const f32x4*)(GA + m0 * 16))[F.tid];
        __syncthreads();
        float cum = 0.f; unsigned kt[32];
#pragma unroll
        for (int r = 0; r < 64; ++r) {
            const f32x4 a0 = ((const f32x4*)sa)[r * 4], a1 = ((const f32x4*)sa)[r * 4 + 1], a2 = ((const f32x4*)sa)[r * 4 + 2], a3 = ((const f32x4*)sa)[r * 4 + 3];
            float z = bj;
            z += a0[0] * w[0] + a0[1] * w[1] + a0[2] * w[2] + a0[3] * w[3];
            z += a1[0] * w[4] + a1[1] * w[5] + a1[2] * w[6] + a1[3] * w[7];
            z += a2[0] * w[8] + a2[1] * w[9] + a2[2] * w[10] + a2[3] * w[11];
            z += a3[0] * w[12] + a3[1] * w[13] + a3[2] * w[14] + a3[3] * w[15];
            cum += pg8::flogsig(z) * 0.0625f;
            const float e = __expf(cum), ei = __expf(-cum);
            const size_t o = (m0 + r) * 512 + j;
            GQ[o] = (bf16)f2bf1(bflo((unsigned)GQ[o]) * e);
            const unsigned kb = f2bf1(bflo((unsigned)GK[o]) * ei);
            GK[o] = (bf16)kb;
            if (r & 1) kt[r >> 1] |= kb << 16; else kt[r >> 1] = kb;
        }
        GD[(size_t)cu * 512 + j] = __expf(cum);
        v4u* kd = (v4u*)(GKT + ((size_t)cu * 512 + j) * 64);
#pragma unroll
        for (int i = 0; i < 8; ++i) { v4u t; t.x = kt[4 * i]; t.y = kt[4 * i + 1]; t.z = kt[4 * i + 2]; t.w = kt[4 * i + 3]; kd[i] = t; }
        for (int h = 0; h < 4; ++h) {
            __syncthreads();
#pragma unroll
            for (int i = 0; i < 4; ++i) { const int q = F.tid + 512 * i, row = q >> 5, cc = q & 31;
                *(v4u*)(sv + row * 264 + cc * 8) = *(const v4u*)(GV + (m0 + row) * 1024 + h * 256 + cc * 8); }
            __syncthreads();
            const int c = F.tid & 255, half = F.tid >> 8;
            unsigned vt[16];
#pragma unroll
            for (int s = 0; s < 16; ++s) vt[s] = (unsigned)sv[(half * 32 + 2 * s) * 264 + c] | ((unsigned)sv[(half * 32 + 2 * s + 1) * 264 + c] << 16);
            v4u* vd = (v4u*)(GVT + ((size_t)cu * 1024 + h * 256 + c) * 64 + half * 32);
#pragma unroll
            for (int i = 0; i < 4; ++i) { v4u t; t.x = vt[4 * i]; t.y = vt[4 * i + 1]; t.z = vt[4 * i + 2]; t.w = vt[4 * i + 3]; vd[i] = t; }
        }
    }
}
__device__ __forceinline__ void gla_scan(const Frame& F) {
    const bf16* GKT = (const bf16*)(F.ar + AR_GKT); const bf16* GVT = (const bf16*)(F.ar + AR_GVT); const float* GD = (const float*)(F.ar + AR_GD); bf16* GST = (bf16*)(F.ar + AR_GST);
    if (F.wave < 4) {
        const int l15 = F.lane & 15, l4 = F.lane >> 4;
        for (int wt = F.bx * 4 + F.wave; wt < 1024; wt += F.G * 4) {
            const int bh = wt >> 7, ib = (wt >> 4) & 7, cb = wt & 15, b = bh >> 2, h = bh & 3;
            const bf16* kp = GKT + ((size_t)b * NCH * 512 + h * 128 + ib * 16 + l15) * 64 + 8 * l4;
            const bf16* vp = GVT + ((size_t)b * NCH * 1024 + h * 256 + cb * 16 + l15) * 64 + 8 * l4;
            const float* dp = GD + (size_t)b * NCH * 512 + h * 128 + ib * 16 + 4 * l4;
            bf16* sp = GST + ((size_t)bh * NCH * 256 + cb * 16 + l15) * 128 + ib * 16 + 4 * l4;
            f32x4 S = {0.f, 0.f, 0.f, 0.f};
            bf16x8 ka[8][2], vb[8][2]; f32x4 dd[8];
#define SC_LOAD(u, n) do { ka[u][0] = *(const bf16x8*)(kp + (size_t)(n) * 32768); ka[u][1] = *(const bf16x8*)(kp + (size_t)(n) * 32768 + 32); \
                           vb[u][0] = *(const bf16x8*)(vp + (size_t)(n) * 65536); vb[u][1] = *(const bf16x8*)(vp + (size_t)(n) * 65536 + 32); \
                           dd[u] = *(const f32x4*)(dp + (size_t)(n) * 512); } while (0)
#pragma unroll
            for (int u = 0; u < 8; ++u) SC_LOAD(u, u);
            for (int n0 = 0; n0 < NCH; n0 += 8) {
#pragma unroll
                for (int u = 0; u < 8; ++u) {
                    const int n = n0 + u;
                    v2u st; st.x = pk2(S[0], S[1]); st.y = pk2(S[2], S[3]);
                    *(v2u*)(sp + (size_t)n * 32768) = st;
                    S = MFMA16(ka[u][0], vb[u][0], S); S = MFMA16(ka[u][1], vb[u][1], S);
                    S = S * dd[u];
                    if (n + 8 < NCH) SC_LOAD(u, n + 8);
                }
            }
#undef SC_LOAD
        }
    }
}
__device__ __forceinline__ void gla_out(const Frame& F, const float* __restrict__ gng, const float* __restrict__ gnb) {
    const bf16* GQ = (const bf16*)(F.ar + AR_GQ); const bf16* GK = (const bf16*)(F.ar + AR_GK); const bf16* GVT = (const bf16*)(F.ar + AR_GVT);
    const bf16* GST = (const bf16*)(F.ar + AR_GST); const bf16* GR = (const bf16*)(F.ar + AR_GR); bf16* OG = (bf16*)(F.ar + AR_GV);
    float* red = (float*)F.lds;
    const int lane = F.lane, r32 = lane & 31, hi = lane >> 5, w = F.wave;
    int par = 0;
    for (int uid = F.bx; uid < NB * NCH * 4; uid += F.G, par ^= 1) {
        const int cu = uid >> 2, h = uid & 3; const size_t m0 = (size_t)cu * 64;
        const int bh = (cu / NCH) * 4 + h, n = cu % NCH;
        f32x16 X00 = {}, X01 = {}, X11 = {};
        const bf16* qb = GQ + (m0 + r32) * 512 + h * 128 + 8 * hi;
        const bf16* kb = GK + (m0 + r32) * 512 + h * 128 + 8 * hi;
#pragma unroll
        for (int ks = 0; ks < 8; ++ks) {
            const bf16x8 q0 = *(const bf16x8*)(qb + ks * 16), q1 = *(const bf16x8*)(qb + 32 * 512 + ks * 16);
            const bf16x8 k0 = *(const bf16x8*)(kb + ks * 16), k1 = *(const bf16x8*)(kb + 32 * 512 + ks * 16);
            X00 = MFMA32(k0, q0, X00); X01 = MFMA32(k0, q1, X01); X11 = MFMA32(k1, q1, X11);
        }
#pragma unroll
        for (int reg = 0; reg < 16; ++reg) { const int sp = (reg & 3) + 8 * (reg >> 2) + 4 * hi; if (sp > r32) { X00[reg] = 0.f; X11[reg] = 0.f; } }
        bf16x8 B00[2], B01[2], B11[2];
#pragma unroll
        for (int sk = 0; sk < 2; ++sk) {
            v4u t;
            t.x = pk2(X00[8 * sk], X00[8 * sk + 1]); t.y = pk2(X00[8 * sk + 2], X00[8 * sk + 3]); t.z = pk2(X00[8 * sk + 4], X00[8 * sk + 5]); t.w = pk2(X00[8 * sk + 6], X00[8 * sk + 7]); B00[sk] = __builtin_bit_cast(bf16x8, t);
            t.x = pk2(X01[8 * sk], X01[8 * sk + 1]); t.y = pk2(X01[8 * sk + 2], X01[8 * sk + 3]); t.z = pk2(X01[8 * sk + 4], X01[8 * sk + 5]); t.w = pk2(X01[8 * sk + 6], X01[8 * sk + 7]); B01[sk] = __builtin_bit_cast(bf16x8, t);
            t.x = pk2(X11[8 * sk], X11[8 * sk + 1]); t.y = pk2(X11[8 * sk + 2], X11[8 * sk + 3]); t.z = pk2(X11[8 * sk + 4], X11[8 * sk + 5]); t.w = pk2(X11[8 * sk + 6], X11[8 * sk + 7]); B11[sk] = __builtin_bit_cast(bf16x8, t);
        }
        f32x16 o0 = {}, o1 = {};
        const bf16* vtp = GVT + ((size_t)cu * 1024 + h * 256 + 32 * w + r32) * 64 + 4 * hi;
#pragma unroll
        for (int stp = 0; stp < 2; ++stp)
#pragma unroll
            for (int sk = 0; sk < 2; ++sk) {
                const v2u lo = *(const v2u*)(vtp + 32 * stp + 16 * sk), hh = *(const v2u*)(vtp + 32 * stp + 16 * sk + 8);
                v4u t; t.x = lo.x; t.y = lo.y; t.z = hh.x; t.w = hh.y; const bf16x8 Av = __builtin_bit_cast(bf16x8, t);
                if (stp == 0) { o0 = MFMA32(Av, B00[sk], o0); o1 = MFMA32(Av, B01[sk], o1); } else { o1 = MFMA32(Av, B11[sk], o1); }
            }
        const bf16* stq = GST + (((size_t)bh * NCH + n) * 256 + 32 * w + r32) * 128 + 8 * hi;
#pragma unroll
        for (int ks = 0; ks < 8; ++ks) {
            const bf16x8 As = *(const bf16x8*)(stq + ks * 16);
            const bf16x8 q0 = *(const bf16x8*)(qb + ks * 16), q1 = *(const bf16x8*)(qb + 32 * 512 + ks * 16);
            o0 = MFMA32(As, q0, o0); o1 = MFMA32(As, q1, o1);
        }
        float s0 = 0.f, q0s = 0.f, s1 = 0.f, q1s = 0.f;
#pragma unroll
        for (int reg = 0; reg < 16; ++reg) { s0 += o0[reg]; q0s += o0[reg] * o0[reg]; s1 += o1[reg]; q1s += o1[reg] * o1[reg]; }
        s0 += __shfl_xor(s0, 32); q0s += __shfl_xor(q0s, 32); s1 += __shfl_xor(s1, 32); q1s += __shfl_xor(q1s, 32);
        if (hi == 0) { float* rp = red + ((par * 8 + w) * 64 + r32) * 2; rp[0] = s0; rp[1] = q0s; rp[64] = s1; rp[65] = q1s; }
        __syncthreads();
        float mean[2], rstd[2];
#pragma unroll
        for (int st = 0; st < 2; ++st) { float ts = 0.f, tq = 0.f;
#pragma unroll
            for (int ww = 0; ww < 8; ++ww) { const float* rp = red + ((par * 8 + ww) * 64 + 32 * st + r32) * 2; ts += rp[0]; tq += rp[1]; }
            mean[st] = ts * (1.f / 256.f); const float var = fmaxf(tq * (1.f / 256.f) - mean[st] * mean[st], 0.f); rstd[st] = 1.f / sqrtf(var + LN_EPS); }
#pragma unroll
        for (int st = 0; st < 2; ++st) {
            const size_t row = m0 + 32 * st + r32;
#pragma unroll
            for (int g = 0; g < 4; ++g) {
                const int gl = h * 256 + 32 * w + 8 * g + 4 * hi;
                const f32x4 gg = *(const f32x4*)(gng + gl), bb = *(const f32x4*)(gnb + gl);
                const v2u rr = *(const v2u*)(GR + row * 1024 + gl);
                const float rv[4] = {bflo(rr.x), bfhi(rr.x), bflo(rr.y), bfhi(rr.y)};
                float y[4];
#pragma unroll
                for (int jj = 0; jj < 4; ++jj) { const float ov = (st == 0) ? o0[4 * g + jj] : o1[4 * g + jj];
                    y[jj] = ((ov - mean[st]) * rstd[st] * gg[jj] + bb[jj]) * (rv[jj] * pg8::fsigmoid(rv[jj])); }
                v2u ow; ow.x = pk2(y[0], y[1]); ow.y = pk2(y[2], y[3]);
                *(v2u*)(OG + row * 1024 + gl) = ow;
            }
        }
    }
}
__global__ void __launch_bounds__(NWAVES * 64, 2) yoco_fwd(Args a) {
    extern __shared__ __attribute__((aligned(16))) unsigned char lds_raw[];
    cg::grid_group grid = cg::this_grid();
    Frame F;
    F.lds = lds_raw; F.ws = a.ws; F.ar = a.ws + WS_AR;
    F.tid = threadIdx.x; F.lane = F.tid & 63; F.wave = __builtin_amdgcn_readfirstlane(F.tid >> 6); F.bx = blockIdx.x;
    F.G = gridDim.x; F.gw = blockIdx.x * NWAVES + F.wave; F.NGW = F.G * NWAVES;
    {
        const float** const tab0 = (const float**)(a.ws + 64);
        if (F.tid == 0 && blockIdx.x == 0) {
            tab0[0] = a.in[0]; tab0[1] = a.in[1]; tab0[2] = a.in[2]; tab0[3] = a.in[3]; tab0[4] = a.in[4]; tab0[5] = a.in[5]; tab0[6] = a.in[6]; tab0[7] = a.in[7];
            tab0[8] = a.in[8]; tab0[9] = a.in[9]; tab0[10] = a.in[10]; tab0[11] = a.in[11]; tab0[12] = a.in[12]; tab0[13] = a.in[13]; tab0[14] = a.in[14]; tab0[15] = a.in[15];
            tab0[16] = a.in[16]; tab0[17] = a.in[17]; tab0[18] = a.in[18]; tab0[19] = a.in[19]; tab0[20] = a.in[20]; tab0[21] = a.in[21]; tab0[22] = a.in[22]; tab0[23] = a.in[23];
        }
    }
#define TAB(i) (tab[(i)])
    convert_weights(F, a.in[2], a.in[18], a.in[3], a.in[19], a.in[20], a.in[21], a.in[6], a.in[14], a.in[11], a.in[15], a.in[12], 0, true);
    cvt_rows(F, a.in[0], (bf16*)(a.ws + WS_XB), (size_t)M * D);
    grid.sync();

    volatile int* const ctl = (volatile int*)(lds_raw + LDS_BYTES - 16);
    if (threadIdx.x == 0) ctl[0] = 0;
    __syncthreads();
    for (;;) {
        {
            const int step = __builtin_amdgcn_readfirstlane(ctl[0]);
            if (step >= 49) break;
            const int L = (step < 13) ? 0 : (step < 26 ? 1 : (step < 38 ? 2 : 3));
            const int st = step - ((L == 0) ? 0 : (L == 1 ? 13 : (L == 2 ? 26 : 38)));
            const unsigned long long prog = (L < 2) ? 0xCBA9876543210ull : (L == 2 ? 0xCBA987FE210Dull : 0xCBA987FE210ull);
            const int code = (int)((prog >> (4 * st)) & 15ull);
#define STEP_FRAME() \
            const unsigned char* ka = (const unsigned char*)__builtin_amdgcn_kernarg_segment_ptr(); \
            unsigned char* ws = *(unsigned char* const volatile*)(ka + 25 * 8); float* X = *(float* const volatile*)(ka + 24 * 8); \
            F.lds = lds_raw; F.ws = ws; F.ar = ws + WS_AR; \
            { int t_ = threadIdx.x, b_ = blockIdx.x, g_ = gridDim.x; asm volatile("" : "+v"(t_), "+s"(b_), "+s"(g_)); F.tid = t_; F.bx = b_; F.G = g_; } \
            F.lane = F.tid & 63; F.wave = __builtin_amdgcn_readfirstlane(F.tid >> 6); \
            F.gw = F.bx * NWAVES + F.wave; F.NGW = F.G * NWAVES; \
            LAS unsigned char* lds3 = (LAS unsigned char*)lds_raw; \
            const float** const tab = (const float**)(ws + 64); \
            bf16* const Wb = (bf16*)(ws + WS_W); bf16* const XB = (bf16*)(ws + WS_XB); bf16* const HB = (bf16*)(F.ar + AR_H); bf16* const PB = (bf16*)(F.ar + AR_PB); bf16* const PLEB = (bf16*)(F.ar + AR_PLE); \
            bf16* const KSH = (bf16*)(F.ar + AR_KSH); bf16* const VSH = (bf16*)(F.ar + AR_VSH); float* const CSH = (float*)(F.ar + AR_CSH); float* const FLOG = (float*)(F.ar + AR_FLOG); \
            (void)lds3; (void)tab; (void)Wb; (void)XB; (void)HB; (void)PB; (void)PLEB; (void)KSH; (void)VSH; (void)CSH; (void)FLOG; (void)X;
            switch (code) {
#ifndef NO_SWIGLU
            case 0: case 10: { STEP_FRAME()
#ifndef NO_PLE
                if (code == 10) {
                    pg8::Gemm g{XB, Wb + OW_PG, M, D, D}; pg8::StaticOrder S; S.init(M, D, F.G, F.bx);
                    pg8::EpiPle E{PLEB};
                    pg8::gemm_phase<pg8::EpiPle, pg8::StaticOrder, PG8_ALIGN, PG8_SP2>(lds3, g, S, E);
                }
#endif
                pg8::Gemm g{XB, Wb + (code == 0 ? OW_F1IN : OW_F2IN), M, 2 * FF, D}; pg8::StaticOrder S; S.init(M, 2 * FF, F.G, F.bx);
                pg8::EpiSwiGLU E{HB, FF};
                pg8::gemm_phase<pg8::EpiSwiGLU, pg8::StaticOrder, PG8_ALIGN, PG8_SP2>(lds3, g, S, E);
            } break;
#endif
#ifndef NO_RES
            case 1: case 7: case 11: { STEP_FRAME()
                const bf16* A = (code == 7) ? ((L < 2) ? (const bf16*)(F.ar + AR_GV) : (const bf16*)(F.ar + AR_FQ)) : HB;
                const bf16* Wt = Wb + (code == 1 ? OW_F1OUT : (code == 7 ? OW_MIXO : OW_F2OUT));
                const int K = (code == 7) ? D : FF;
                const float* base = (L == 0 && code == 1) ? TAB(0) : X;
                pg8::Gemm g{A, Wt, M, D, K}; pg8::StaticOrder S; S.init(M, D, F.G, F.bx);
                pg8::EpiRes E{base, X, (code == 11) ? PLEB : nullptr, DN_ALPHA, (code == 7) ? 1.f : 0.5f};
                pg8::gemm_phase<pg8::EpiRes, pg8::StaticOrder, PG8_ALIGN, PG8_SP2>(lds3, g, S, E);
            } break;
#endif
#ifndef NO_LN
            case 2: case 8: case 12: { STEP_FRAME()
                const int gi = (code == 2) ? 4 : (code == 8 ? 16 : 22);
                ln_phase(F, TAB(gi) + L * D, TAB(gi + 1) + L * D, X, XB);
                if (code == 2 && L == 2) cumsum_phase(F, FLOG, CSH);
                if (code == 8) cvt_rows(F, TAB(1) + (size_t)L * M * PLE, PB, (size_t)M * PLE);
                if (code == 12 && L + 1 < DEPTH) convert_weights(F, TAB(2), TAB(18), TAB(3), TAB(19), TAB(20), TAB(21), TAB(6), TAB(14), TAB(11), TAB(15), TAB(12), L + 1, false);
            } break;
#endif
#ifndef NO_SPLIT
            case 3: case 9: case 13: case 14: { STEP_FRAME()
                const int mode = (code == 3) ? 0 : (code == 9 ? 1 : (code == 13 ? 2 : 3));
                const pg8::Gemm g{(code == 9) ? PB : XB, Wb + (code == 9 ? OW_PP : (code == 13 ? OW_KVF : OW_MIXIN)), M, (code == 3) ? GLA_INP : (code == 9 ? D : (code == 13 ? KVF_NP : 2048)), (code == 9) ? PLE : D};
                const pg8::EpiSplit E{F.ar, mode, TAB(13)};
                pg8::StaticOrder S; S.init(g.M, g.N, F.G, F.bx);
                pg8::gemm_phase<pg8::EpiSplit, pg8::StaticOrder, PG8_ALIGN, PG8_SP2>(lds3, g, S, E);
            } break;
#endif
#ifndef NO_PREP
            case 4: { STEP_FRAME() gla_prep(F, TAB(7) + (size_t)L * 16 * 512, TAB(8) + L * 512); } break;
#endif
#ifndef NO_SCAN
            case 5: { STEP_FRAME() gla_scan(F); } break;
#endif
#ifndef NO_OUT
            case 6: { STEP_FRAME() gla_out(F, TAB(9) + L * D, TAB(10) + L * D); } break;
#endif
#ifndef NO_ATTN
            case 15: { STEP_FRAME()
                const attn_body::AttnTensors AT{(const attn_body::bf16*)(F.ar + AR_FQ), (const attn_body::bf16*)KSH, (const attn_body::bf16*)VSH, (attn_body::bf16*)(F.ar + AR_FQ),
                                                (const attn_body::bf16*)(F.ar + AR_FG), CSH};
                const attn_body::StaticOrder S((int)F.G, F.bx);
                attn_body::attn_phase<attn_body::StaticOrder>((char*)lds_raw, AT, S);
            } break;
#endif
            default: break;
            }
        }
        if (threadIdx.x == 0) ctl[0] = ctl[0] + 1;
        grid.sync();
    }
}

extern "C" void kernel_launch(void* const* d_in, const int* in_sizes, int n_in, void* d_out, int out_size, void* d_ws, size_t ws_size, hipStream_t stream) {
    static int grid = 0;
    if (grid == 0) {
        if (n_in != 24 || out_size != M * D || ws_size < WS_END) { fprintf(stderr, "kernel_launch: unexpected shapes (n_in %d, out %d, ws %zu)\n", n_in, out_size, ws_size); grid = -1; return; }
        int dev = 0, cus = 0, per_cu = 0;
        if (hipGetDevice(&dev) != hipSuccess || hipDeviceGetAttribute(&cus, hipDeviceAttributeMultiprocessorCount, dev) != hipSuccess) { grid = -1; return; }
        if (hipFuncSetAttribute((const void*)yoco_fwd, hipFuncAttributeMaxDynamicSharedMemorySize, LDS_BYTES) != hipSuccess) { fprintf(stderr, "kernel_launch: hipFuncSetAttribute failed\n"); grid = -1; return; }
        if (hipOccupancyMaxActiveBlocksPerMultiprocessor(&per_cu, (const void*)yoco_fwd, NWAVES * 64, LDS_BYTES) != hipSuccess || per_cu < 1) per_cu = 1;
        (void)hipGetLastError();
        grid = cus * per_cu;
    }
    if (grid < 0) return;
    Args a{};
    for (int i = 0; i < 24; ++i) a.in[i] = (const float*)d_in[i];
    a.out = (float*)d_out; a.ws = (unsigned char*)d_ws;
    void* args[] = {&a};
    const hipError_t e = hipLaunchCooperativeKernel((const void*)yoco_fwd, dim3(grid), dim3(NWAVES * 64), args, LDS_BYTES, stream);
    if (e != hipSuccess) fprintf(stderr, "kernel_launch: cooperative launch failed: %s (grid %d)\n", hipGetErrorString(e), grid);
}
```

```cpp
#include <hip/hip_runtime.h>
#include <hip/hip_cooperative_groups.h>
#include <cstdio>
#include <cstdint>
namespace cg = cooperative_groups;
namespace pg8 {
#define PG8_LAS __attribute__((address_space(3)))
typedef unsigned short bf16_t;
typedef short bf16x8 __attribute__((ext_vector_type(8)));
typedef float f32x4 __attribute__((ext_vector_type(4)));
typedef unsigned u32x4 __attribute__((ext_vector_type(4)));
constexpr int BM = 256, BK = 64, HALF = 128, HTB = HALF * BK * 2  , STAGE_BYTES = 8 * HTB, NXCD = 8, WGM = 8;

__host__ __device__ __forceinline__ int lds_byte(int r, int c) { const int st = (r >> 4) * 2 + (c >> 5), rr = r & 15, cc = c & 31, ob = rr * 64 + cc * 2; return st * 1024 + (ob ^ (((ob >> 9) & 1) << 5)); }
__host__ __device__ __forceinline__ void stage_rc(int b, int& R, int& C) { const int st = b / 1024, sb = b % 1024, swz = sb ^ (((sb >> 9) & 1) << 5); R = (st >> 1) * 16 + swz / 64; C = (st & 1) * 32 + (swz % 64) / 2; }
__host__ __device__ __forceinline__ int perm32(int rho) { const int n = rho >> 4, i = rho & 15; return 8 * (i >> 2) + 4 * n + (i & 3); }

struct Unit { int pm, pn; };
struct Gemm { const bf16_t* A; const bf16_t* Bt; int M, N, K; };

struct StaticOrder {
    int nM, nN, nwg, G, c;
    __host__ __device__ void init(int M, int N, int G_, int c_) { nM = M / BM; nN = N / BM; nwg = nM * nN; G = G_; c = c_; }
    __host__ __device__ bool next(int i, Unit& u) const {
        const long L = (long)i * G + c; if (L >= nwg) return false;
        int wgid = (int)L; { const int q = nwg / NXCD, r = nwg % NXCD, xcd = wgid % NXCD, off = wgid / NXCD; wgid = (xcd < r ? xcd * (q + 1) : r * (q + 1) + (xcd - r) * q) + off; }
        const int nig = WGM * nN, gid = wgid / nig, fm = gid * WGM, gsz = (nM - fm) < WGM ? (nM - fm) : WGM;
        u.pm = fm + ((wgid % nig) % gsz); u.pn = (wgid % nig) / gsz; return true;
    }
    __device__ __forceinline__ void a_ready(const Unit&) const {}
    __device__ __forceinline__ void done(const Unit&) const {}
};

__device__ __forceinline__ unsigned cvt_pk_bf16(float lo, float hi) { unsigned r; asm volatile("v_cvt_pk_bf16_f32 %0, %1, %2" : "=v"(r) : "v"(lo), "v"(hi)); return r; }
__device__ __forceinline__ float fsigmoid(float x) { return __builtin_amdgcn_rcpf(1.f + __builtin_amdgcn_exp2f(-1.4426950408889634f * x)); }
__device__ __forceinline__ float bf_lo(unsigned w) { return __uint_as_float(w << 16); }
__device__ __forceinline__ float bf_hi(unsigned w) { return __uint_as_float(w & 0xffff0000u); }
__device__ __forceinline__ float flogsig(float z) { return fminf(z, 0.f) - __logf(1.f + __expf(-fabsf(z))); }
typedef unsigned u32x2 __attribute__((ext_vector_type(2)));
#define EPI_IDS() { int t_ = threadIdx.x; asm volatile("" : "+v"(t_)); const int l_ = t_ & 63, w_ = __builtin_amdgcn_readfirstlane(t_ >> 6); wr = w_ >> 2; wc = w_ & 3; fr = l_ & 15; fq = l_ >> 4; }


struct EpiSwiGLU {
    static constexpr bool PERM = true, AFTER_DRAIN = false;
    bf16_t* H; int ldh;
    __device__ __forceinline__ void operator()(const f32x4 (&acc)[2][2][4][2], const Unit& u, int wr, int wc, int fr, int fq) const {
        EPI_IDS();
        const int row0 = u.pm * BM + wr * 64 + fr, col0 = u.pn * HALF + wc * 32 + 8 * fq;
#pragma unroll
        for (int ai = 0; ai < 2; ++ai)
#pragma unroll
            for (int m = 0; m < 4; ++m) {
                bf16_t* p = H + (size_t)(row0 + ai * HALF + m * 16) * ldh + col0;
                const f32x4 g0 = acc[ai][0][m][0], g1 = acc[ai][0][m][1], u0 = acc[ai][1][m][0], u1 = acc[ai][1][m][1];
                float h[8];
#pragma unroll
                for (int j = 0; j < 4; ++j) { h[j] = g0[j] * fsigmoid(g0[j]) * u0[j]; h[4 + j] = g1[j] * fsigmoid(g1[j]) * u1[j]; }
                u32x4 w; w.x = cvt_pk_bf16(h[0], h[1]); w.y = cvt_pk_bf16(h[2], h[3]); w.z = cvt_pk_bf16(h[4], h[5]); w.w = cvt_pk_bf16(h[6], h[7]);
                *(u32x4*)p = w;
            }
    }
};
struct EpiRes {
    static constexpr bool PERM = false, AFTER_DRAIN = false;
    const float* base; float* out; const bf16_t* add; float alpha, s;
    __device__ __forceinline__ void operator()(const f32x4 (&acc)[2][2][4][2], const Unit& u, int wr, int wc, int fr, int fq) const {
        EPI_IDS();
        const int row0 = u.pm * BM + wr * 64 + fr, col0 = u.pn * BM + wc * 32 + 4 * fq;
#pragma unroll
        for (int ai = 0; ai < 2; ++ai)
#pragma unroll
            for (int m = 0; m < 4; ++m) {
                const size_t off = (size_t)(row0 + ai * HALF + m * 16) * 1024 + col0;
#pragma unroll
                for (int bj = 0; bj < 2; ++bj)
#pragma unroll
                    for (int n = 0; n < 2; ++n) {
                        const size_t o = off + bj * HALF + n * 16;
                        const f32x4 b = *(const f32x4*)(base + o);
                        f32x4 v = b * alpha + acc[ai][bj][m][n] * s;
                        if (add) { const u32x2 a = *(const u32x2*)(add + o); v[0] += bf_lo(a.x); v[1] += bf_hi(a.x); v[2] += bf_lo(a.y); v[3] += bf_hi(a.y); }
                        *(f32x4*)(out + o) = v;
                    }
            }
    }
};
struct EpiSplit {
    static constexpr bool PERM = true, AFTER_DRAIN = false;
    unsigned char* ar; int mode; const float* tbias;
    __device__ __forceinline__ void operator()(const f32x4 (&acc)[2][2][4][2], const Unit& u, int wr, int wc, int fr, int fq) const {
        EPI_IDS();
        const int pn = u.pn; const int row0 = u.pm * BM + wr * 64 + fr;
        const int tail_tile = (mode == 0) ? 12 : (mode == 2 ? 8 : -1);
        if (pn == tail_tile) {
            float* tail = (float*)(ar + ((mode == 0) ? (size_t)192 << 20 : (size_t)474 << 20));
            if (wc == 0 && fq < 2) {
#pragma unroll
                for (int ai = 0; ai < 2; ++ai)
#pragma unroll
                    for (int m = 0; m < 4; ++m)
#pragma unroll
                        for (int n = 0; n < 2; ++n) {
                            f32x4 v = acc[ai][0][m][n]; const int c = 8 * fq + 4 * n;
                            if (mode == 2) {
#pragma unroll
                                for (int j = 0; j < 4; ++j) v[j] = flogsig(v[j] + tbias[c + j]);
                            }
                            *(f32x4*)(tail + (size_t)(row0 + ai * HALF + m * 16) * 16 + c) = v;
                        }
            }
            return;
        }
        size_t boff; int ld, tb; float sc = 1.f;
        if (mode == 0) { if (pn < 2) { boff = 0; ld = 512; tb = 0; sc = 0.08838834764831845f; } else if (pn < 4) { boff = (size_t)32 << 20; ld = 512; tb = 2; } else if (pn < 8) { boff = (size_t)64 << 20; ld = 1024; tb = 4; } else { boff = (size_t)128 << 20; ld = 1024; tb = 8; } }
        else if (mode == 1) { boff = (size_t)280 << 20; ld = 1024; tb = 0; }
        else if (mode == 2) { if (pn < 4) { boff = (size_t)344 << 20; tb = 0; } else { boff = (size_t)408 << 20; tb = 4; } ld = 1024; }
        else { if (pn < 4) { boff = 0; tb = 0; sc = 0.125f * 1.4426950408889634f; } else { boff = (size_t)64 << 20; tb = 4; } ld = 1024; }
        bf16_t* base = (bf16_t*)(ar + boff);
        const int col0 = (pn - tb) * BM + wc * 32 + 8 * fq;
#pragma unroll
        for (int ai = 0; ai < 2; ++ai)
#pragma unroll
            for (int m = 0; m < 4; ++m) {
                bf16_t* rowp = base + (size_t)(row0 + ai * HALF + m * 16) * ld + col0;
#pragma unroll
                for (int bj = 0; bj < 2; ++bj) {
                    const f32x4 v0 = acc[ai][bj][m][0] * sc, v1 = acc[ai][bj][m][1] * sc;
                    u32x4 w; w.x = cvt_pk_bf16(v0[0], v0[1]); w.y = cvt_pk_bf16(v0[2], v0[3]); w.z = cvt_pk_bf16(v1[0], v1[1]); w.w = cvt_pk_bf16(v1[2], v1[3]);
                    *(u32x4*)(rowp + bj * HALF) = w;
                }
            }
    }
};
struct EpiPle {
    static constexpr bool PERM = true, AFTER_DRAIN = false;
    bf16_t* P;
    __device__ __forceinline__ void operator()(const f32x4 (&acc)[2][2][4][2], const Unit& u, int wr, int wc, int fr, int fq) const {
        EPI_IDS();
        const int row0 = u.pm * BM + wr * 64 + fr, col0 = u.pn * BM + wc * 32 + 8 * fq;
#pragma unroll
        for (int ai = 0; ai < 2; ++ai)
#pragma unroll
            for (int m = 0; m < 4; ++m) {
                bf16_t* rowp = P + (size_t)(row0 + ai * HALF + m * 16) * 1024 + col0;
#pragma unroll
                for (int bj = 0; bj < 2; ++bj) {
                    const u32x4 pv = *(const u32x4*)(rowp + bj * HALF);
                    const f32x4 v0 = acc[ai][bj][m][0], v1 = acc[ai][bj][m][1];
                    u32x4 w;
                    w.x = cvt_pk_bf16(fsigmoid(v0[0]) * bf_lo(pv.x), fsigmoid(v0[1]) * bf_hi(pv.x));
                    w.y = cvt_pk_bf16(fsigmoid(v0[2]) * bf_lo(pv.y), fsigmoid(v0[3]) * bf_hi(pv.y));
                    w.z = cvt_pk_bf16(fsigmoid(v1[0]) * bf_lo(pv.z), fsigmoid(v1[1]) * bf_hi(pv.z));
                    w.w = cvt_pk_bf16(fsigmoid(v1[2]) * bf_lo(pv.w), fsigmoid(v1[3]) * bf_hi(pv.w));
                    *(u32x4*)(rowp + bj * HALF) = w;
                }
            }
    }
};

template <class Epi, class Sched, bool ALIGN_EPI = false, bool SP2 = false>
__device__ __forceinline__ void gemm_phase(PG8_LAS unsigned char* lds, const Gemm g, const Sched& S, const Epi& E) {
    int tid = threadIdx.x; asm volatile("" : "+v"(tid)); const int wid = __builtin_amdgcn_readfirstlane(tid >> 6), lane = tid & 63, wr = wid >> 2, wc = wid & 3, fr = lane & 15, fq = lane >> 4;
    const int K = g.K, nt = K / BK;
    unsigned voffA[2], voffB[2];
#pragma unroll
    for (int i = 0; i < 2; ++i) { int R, C; stage_rc(tid * 16 + i * 8192, R, C); const int Rb = Epi::PERM ? ((R & ~31) + perm32(R & 31)) : R;
        voffA[i] = (unsigned)(R * K + C) * 2u; voffB[i] = (unsigned)(Rb * K + C) * 2u; }
    const size_t kstep = (size_t)(BK * 2);
    const size_t hstep = (size_t)HALF * K * 2;
    const size_t tstep = 2 * hstep;
    const unsigned ldsw = (unsigned)wid * 1024u;
    const int aoff = lds_byte(wr * 64 + fr, fq * 8), boff = lds_byte(wc * 32 + fr, fq * 8);
#define PG8_SA(b, h) (((b) * 2 + (h)) * HTB)
#define PG8_SB(b, h) ((4 + (b) * 2 + (h)) * HTB)
#define PG8_STAGE(bufoff, gbase, voff) do { _Pragma("unroll") for (int _i = 0; _i < 2; ++_i) \
        __builtin_amdgcn_global_load_lds((const unsigned*)((const char*)(gbase) + (voff)[_i]), (PG8_LAS unsigned*)(lds + (bufoff) + ldsw + _i * 8192), 16, 0, 0); } while (0)
#define PG8_LDA(dst, b, h) do { _Pragma("unroll") for (int m = 0; m < 4; ++m) _Pragma("unroll") for (int k = 0; k < 2; ++k) dst[m][k] = *(const PG8_LAS bf16x8*)(lds + PG8_SA(b, h) + aoff + m * 2048 + k * 1024); } while (0)
#define PG8_LDB(dst, b, h) do { _Pragma("unroll") for (int n = 0; n < 2; ++n) _Pragma("unroll") for (int k = 0; k < 2; ++k) dst[n][k] = *(const PG8_LAS bf16x8*)(lds + PG8_SB(b, h) + boff + n * 2048 + k * 1024); } while (0)
#define PG8_MMA(ai, bj, At, Bt) do { __builtin_amdgcn_s_setprio(1); _Pragma("unroll") for (int m = 0; m < 4; ++m) _Pragma("unroll") for (int n = 0; n < 2; ++n) _Pragma("unroll") for (int k = 0; k < 2; ++k) \
        acc[ai][bj][m][n] = __builtin_amdgcn_mfma_f32_16x16x32_bf16(Bt[n][k], At[m][k], acc[ai][bj][m][n], 0, 0, 0); __builtin_amdgcn_s_setprio(0); } while (0)
#define PG8_WAIT_V(n) asm volatile("s_waitcnt vmcnt(" #n ")" ::: "memory")
#define PG8_WAIT_L(n) asm volatile("s_waitcnt lgkmcnt(" #n ")" ::: "memory")
#define PG8_BAR __builtin_amdgcn_s_barrier()
#define PG8_SCHED __builtin_amdgcn_sched_barrier(0)
    Unit cur, nxt; int ui = 0;
    if (!S.next(0, cur)) return;
    f32x4 acc[2][2][4][2];
#pragma unroll
    for (int a = 0; a < 2; ++a)
#pragma unroll
        for (int b = 0; b < 2; ++b)
#pragma unroll
            for (int m = 0; m < 4; ++m)
#pragma unroll
                for (int n = 0; n < 2; ++n) acc[a][b][m][n] = (f32x4){0.f, 0.f, 0.f, 0.f};
    bf16x8 At[4][2], B0[2][2], B1[2][2];
    const char* cA = (const char*)g.A + (size_t)cur.pm * tstep; const char* cB = (const char*)g.Bt + (size_t)cur.pn * tstep;
    S.a_ready(cur);
    if constexpr (SP2) {
        PG8_STAGE(PG8_SB(0, 0), cB, voffB); PG8_STAGE(PG8_SB(0, 1), cB + hstep, voffB); PG8_STAGE(PG8_SA(0, 0), cA, voffA); PG8_STAGE(PG8_SA(0, 1), cA + hstep, voffA);
        if (wr == 1) PG8_BAR;
        PG8_WAIT_V(2); PG8_BAR;
        PG8_STAGE(PG8_SB(1, 0), cB + kstep, voffB); PG8_STAGE(PG8_SA(1, 0), cA + kstep, voffA); PG8_STAGE(PG8_SB(1, 1), cB + hstep + kstep, voffB);
        PG8_WAIT_V(6); PG8_BAR;
    } else {
        PG8_STAGE(PG8_SB(0, 0), cB, voffB); PG8_STAGE(PG8_SA(0, 0), cA, voffA); PG8_STAGE(PG8_SB(0, 1), cB + hstep, voffB); PG8_STAGE(PG8_SA(0, 1), cA + hstep, voffA);
        if (wr == 1) PG8_BAR;
        PG8_WAIT_V(4); PG8_BAR;
        PG8_STAGE(PG8_SB(1, 0), cB + kstep, voffB); PG8_STAGE(PG8_SA(1, 0), cA + kstep, voffA); PG8_STAGE(PG8_SB(1, 1), cB + hstep + kstep, voffB);
        PG8_WAIT_V(6); PG8_BAR;
    }
    for (;;) {
        const bool has_next = S.next(ui + 1, nxt);
        const char* nA = has_next ? (const char*)g.A + (size_t)nxt.pm * tstep : cA; const char* nB = has_next ? (const char*)g.Bt + (size_t)nxt.pn * tstep : cB;
        for (int t = 0; t < nt; t += 2) {
            const bool last = (t == nt - 2);
            const char* a1 = cA + (size_t)(t + 1) * kstep;
            const char* a2 = last ? nA : cA + (size_t)(t + 2) * kstep; const char* b2 = last ? nB : cB + (size_t)(t + 2) * kstep;
            const char* a3 = a2 + kstep; const char* b3 = b2 + kstep;
            if (last && has_next) S.a_ready(nxt);
            if constexpr (SP2) {
            PG8_LDB(B0, 0, 0); PG8_LDB(B1, 0, 1); PG8_SCHED; PG8_LDA(At, 0, 0); PG8_STAGE(PG8_SA(1, 1), a1 + hstep, voffA);
            PG8_WAIT_V(8); PG8_WAIT_L(0); PG8_BAR; PG8_MMA(0, 0, At, B0); PG8_MMA(0, 1, At, B1); PG8_BAR; PG8_SCHED;
            PG8_LDA(At, 0, 1); PG8_STAGE(PG8_SB(0, 0), b2, voffB); PG8_STAGE(PG8_SB(0, 1), b2 + hstep, voffB); PG8_STAGE(PG8_SA(0, 0), a2, voffA);
            PG8_WAIT_V(8); PG8_WAIT_L(0); PG8_BAR; PG8_MMA(1, 0, At, B0); PG8_MMA(1, 1, At, B1); PG8_BAR; PG8_SCHED;
            PG8_LDB(B0, 1, 0); PG8_LDB(B1, 1, 1); PG8_SCHED; PG8_LDA(At, 1, 0); PG8_STAGE(PG8_SA(0, 1), a2 + hstep, voffA);
            PG8_WAIT_V(8); PG8_WAIT_L(0); PG8_BAR; PG8_MMA(0, 0, At, B0); PG8_MMA(0, 1, At, B1); PG8_BAR; PG8_SCHED;
            PG8_LDA(At, 1, 1); PG8_STAGE(PG8_SB(1, 0), b3, voffB); PG8_STAGE(PG8_SB(1, 1), b3 + hstep, voffB); PG8_STAGE(PG8_SA(1, 0), a3, voffA);
            PG8_WAIT_V(8); PG8_WAIT_L(0); PG8_BAR; PG8_MMA(1, 0, At, B0); PG8_MMA(1, 1, At, B1); PG8_BAR; PG8_SCHED;
            } else {
            PG8_LDB(B0, 0, 0); PG8_SCHED; PG8_LDA(At, 0, 0); PG8_STAGE(PG8_SA(1, 1), a1 + hstep, voffA);
            PG8_WAIT_L(8); PG8_BAR; PG8_WAIT_L(0); PG8_MMA(0, 0, At, B0); PG8_BAR; PG8_SCHED;
            PG8_LDB(B1, 0, 1); PG8_STAGE(PG8_SB(0, 0), b2, voffB);
            PG8_BAR; PG8_WAIT_L(0); PG8_MMA(0, 1, At, B1); PG8_BAR;
            PG8_LDA(At, 0, 1); PG8_STAGE(PG8_SA(0, 0), a2, voffA);
            PG8_BAR; PG8_WAIT_L(0); PG8_MMA(1, 0, At, B0); PG8_BAR; PG8_SCHED;
            PG8_STAGE(PG8_SB(0, 1), b2 + hstep, voffB);
            PG8_WAIT_V(6); PG8_BAR; PG8_MMA(1, 1, At, B1); PG8_BAR;
            PG8_LDB(B0, 1, 0); PG8_SCHED; PG8_LDA(At, 1, 0); PG8_STAGE(PG8_SA(0, 1), a2 + hstep, voffA);
            PG8_WAIT_L(8); PG8_BAR; PG8_WAIT_L(0); PG8_MMA(0, 0, At, B0); PG8_BAR; PG8_SCHED;
            PG8_LDB(B1, 1, 1); PG8_STAGE(PG8_SB(1, 0), b3, voffB);
            PG8_BAR; PG8_WAIT_L(0); PG8_MMA(0, 1, At, B1); PG8_BAR;
            PG8_LDA(At, 1, 1); PG8_STAGE(PG8_SA(1, 0), a3, voffA);
            PG8_BAR; PG8_WAIT_L(0); PG8_MMA(1, 0, At, B0); PG8_BAR; PG8_SCHED;
            PG8_STAGE(PG8_SB(1, 1), b3 + hstep, voffB);
            PG8_WAIT_V(6); PG8_BAR; PG8_MMA(1, 1, At, B1); PG8_BAR;
            }
        }
        if constexpr (ALIGN_EPI) { if (wr == 0) PG8_BAR; }
        if constexpr (!Epi::AFTER_DRAIN) { E(acc, cur, wr, wc, fr, fq); S.done(cur); }
        if (!has_next) break;
#pragma unroll
        for (int a = 0; a < 2; ++a)
#pragma unroll
            for (int b = 0; b < 2; ++b)
#pragma unroll
                for (int m = 0; m < 4; ++m)
#pragma unroll
                    for (int n = 0; n < 2; ++n) acc[a][b][m][n] = (f32x4){0.f, 0.f, 0.f, 0.f};
        cur = nxt; cA = nA; cB = nB; ++ui;
        if constexpr (ALIGN_EPI) { if (wr == 1) PG8_BAR; }
    }
    PG8_WAIT_V(0);
    if constexpr (!ALIGN_EPI) { if (wr == 0) PG8_BAR; }
    PG8_BAR;
    if constexpr (Epi::AFTER_DRAIN) { E.fused(acc, cur, wr, wc, fr, fq, lds, wid, lane); S.done(cur); }
#undef PG8_SA
#undef PG8_SB
#undef PG8_STAGE
#undef PG8_LDA
#undef PG8_LDB
#undef PG8_MMA
#undef PG8_WAIT_V
#undef PG8_WAIT_L
#undef PG8_BAR
#undef PG8_SCHED
}
}
#include <hip/hip_bf16.h>
#include <cmath>
namespace attn_body {
using bf16=__hip_bfloat16;
using bf16x8=__attribute__((ext_vector_type(8)))short;
using s16x4=__attribute__((ext_vector_type(4)))short;
using f32x16=__attribute__((ext_vector_type(16)))float;
using u32x4=__attribute__((ext_vector_type(4)))unsigned;
constexpr int BATCH=2,NHEAD=16,SEQ=16384,D=64,DM=NHEAD*D;
constexpr int NW=8,QBLK=32,QB=QBLK*NW,KVBLK=64,NQB=SEQ/QB;
constexpr int ATTN_PITCH=DM, ATTN_UNIT_ROWS=QB;
__device__ __forceinline__ int crow(int r,int hi){return (r&3)+8*(r>>2)+4*hi;}
#define SBAR() __builtin_amdgcn_sched_barrier(0)
__device__ __forceinline__ void cmask(f32x16&p0,f32x16&p1,int jb,int qrel,int hi){
  const float NEG=-INFINITY; int kb=64*jb+4*hi;
  #pragma unroll
  for(int r=0;r<16;++r){int kv=kb+(r&3)+8*(r>>2); if(kv>qrel)p0[r]=NEG; if(kv+32>qrel)p1[r]=NEG;}
}

constexpr int NSLOT=3, SLOTB=8192;
constexpr int LDS_K=0, LDS_V=NSLOT*SLOTB, LDS_WS=2*NSLOT*SLOTB, LDS_OST=LDS_WS+NW*64*4, LDS_BETA=LDS_OST+NW*4096, LDS_MISC=LDS_BETA+SEQ*4, LDS_BYTES=LDS_MISC+64;
constexpr float C2=0.125f*1.4426950408889634f;
__device__ __forceinline__ void glds16(const void*gsrc,unsigned lds_dst){unsigned keep;
  asm volatile("s_mov_b32 %0, m0\n\ts_mov_b32 m0, %2\n\ts_nop 0\n\tglobal_load_lds_dwordx4 %1, off\n\ts_mov_b32 m0, %0":"=&s"(keep):"v"(gsrc),"s"(lds_dst):"memory");}
__device__ __forceinline__ float max3f(float a,float b,float c){float r;asm("v_max3_f32 %0, %1, %2, %3":"=v"(r):"v"(a),"v"(b),"v"(c));return r;}
__device__ __forceinline__ float max2f(float a,float b){float r;asm("v_max_f32_e32 %0, %1, %2":"=v"(r):"v"(a),"v"(b));return r;}
__device__ __forceinline__ float fadd_s(float a,float b){float r;asm("v_add_f32_e32 %0, %1, %2":"=v"(r):"v"(a),"v"(b));return r;}
__device__ __forceinline__ float fsub_s(float a,float b){float r;asm("v_sub_f32_e32 %0, %1, %2":"=v"(r):"v"(a),"v"(b));return r;}
typedef float f32x4_t __attribute__((ext_vector_type(4))); typedef float f32x2_t __attribute__((ext_vector_type(2))); typedef __bf16 bf16x2_t __attribute__((ext_vector_type(2)));
__device__ __forceinline__ unsigned cvtpk_s(float lo,float hi){f32x2_t v={lo,hi};bf16x2_t b=__builtin_convertvector(v,bf16x2_t);return __builtin_bit_cast(unsigned,b);}
#define WAIT_BAR(N) asm volatile("s_waitcnt vmcnt(" #N ") lgkmcnt(0)\n\ts_barrier":::"memory")

__device__ __forceinline__ void qkt(f32x16&p0,f32x16&p1,const char*Kslot,const bf16x8*qr,const f32x16&negm,int r32,int hi){
  const char*kb=Kslot+hi*1024+r32*16;
  #pragma unroll
  for(int d0=0;d0<4;++d0){
    const bf16x8 b0=*reinterpret_cast<const bf16x8*>(kb+d0*2048);
    const bf16x8 b1=*reinterpret_cast<const bf16x8*>(kb+d0*2048+512);
    if(d0==0){p0=__builtin_amdgcn_mfma_f32_32x32x16_bf16(b0,qr[0],negm,0,0,0);p1=__builtin_amdgcn_mfma_f32_32x32x16_bf16(b1,qr[0],negm,0,0,0);}
    else{p0=__builtin_amdgcn_mfma_f32_32x32x16_bf16(b0,qr[d0],p0,0,0,0);p1=__builtin_amdgcn_mfma_f32_32x32x16_bf16(b1,qr[d0],p1,0,0,0);}}
}
typedef __attribute__((address_space(3))) const char* lds_cptr;
typedef short v4i16_t __attribute__((ext_vector_type(4)));
__device__ __forceinline__ void kload8(bf16x8*kf,lds_cptr kp){
  kf[0]=*(const __attribute__((address_space(3))) bf16x8*)(kp);      kf[1]=*(const __attribute__((address_space(3))) bf16x8*)(kp+512);
  kf[2]=*(const __attribute__((address_space(3))) bf16x8*)(kp+2048); kf[3]=*(const __attribute__((address_space(3))) bf16x8*)(kp+2560);
  kf[4]=*(const __attribute__((address_space(3))) bf16x8*)(kp+4096); kf[5]=*(const __attribute__((address_space(3))) bf16x8*)(kp+4608);
  kf[6]=*(const __attribute__((address_space(3))) bf16x8*)(kp+6144); kf[7]=*(const __attribute__((address_space(3))) bf16x8*)(kp+6656);
}
__device__ __forceinline__ void kload2(bf16x8*kf,lds_cptr kp,int j){ kf[2*j]=*(const __attribute__((address_space(3))) bf16x8*)(kp+j*2048); kf[2*j+1]=*(const __attribute__((address_space(3))) bf16x8*)(kp+j*2048+512); }
__device__ __forceinline__ s16x4 vtr(lds_cptr p){ return __builtin_bit_cast(s16x4,__builtin_amdgcn_ds_read_tr16_b64_v4i16((__attribute__((address_space(3))) v4i16_t*)p)); }
__device__ __forceinline__ float rowmax(const f32x16&p0,const f32x16&p1){
  float a=max3f(p0[0],p0[1],p1[0]),b=max3f(p0[2],p0[3],p1[1]);a=max3f(a,p1[2],p1[3]);
  #pragma unroll
  for(int r=4;r<16;r+=4){a=max3f(a,p0[r],p0[r+1]);b=max3f(b,p0[r+2],p0[r+3]);a=max3f(a,p1[r],p1[r+1]);b=max3f(b,p1[r+2],p1[r+3]);}
  const float m=max2f(a,b);
  auto rr=__builtin_amdgcn_permlane32_swap(__float_as_uint(m),__float_as_uint(m),false,false);
  return max2f(__uint_as_float(rr[0]),__uint_as_float(rr[1]));
}
__device__ __forceinline__ void pv(f32x16*o,int vb,bf16x8 pa0,bf16x8 pa1,bf16x8 pa2,bf16x8 pa3){
  #pragma unroll
  for(int d0=0;d0<2;++d0){s16x4 lo[4],hi[4];
    #pragma unroll
    for(int ks=0;ks<4;++ks){
      asm volatile("ds_read_b64_tr_b16 %0,%1 offset:%c2":"=&v"(lo[ks]):"v"(vb),"i"(d0*4096+ks*1024):"memory");
      asm volatile("ds_read_b64_tr_b16 %0,%1 offset:%c2":"=&v"(hi[ks]):"v"(vb),"i"(d0*4096+ks*1024+512):"memory");}
    asm volatile("s_waitcnt lgkmcnt(0)":::"memory");SBAR();
    #define PK(k) (bf16x8){lo[k][0],lo[k][1],lo[k][2],lo[k][3],hi[k][0],hi[k][1],hi[k][2],hi[k][3]}
    o[d0]=__builtin_amdgcn_mfma_f32_32x32x16_bf16(pa0,PK(0),o[d0],0,0,0);
    o[d0]=__builtin_amdgcn_mfma_f32_32x32x16_bf16(pa1,PK(1),o[d0],0,0,0);
    o[d0]=__builtin_amdgcn_mfma_f32_32x32x16_bf16(pa2,PK(2),o[d0],0,0,0);
    o[d0]=__builtin_amdgcn_mfma_f32_32x32x16_bf16(pa3,PK(3),o[d0],0,0,0);
    #undef PK
  }
}

#ifndef ATTN_STORE16
#define ATTN_STORE16(p,v) (*(u32x4*)(p)=(v))
#endif
template<int THRL> __device__ __forceinline__ void attn_unit(int b,int h,int qb,const bf16*Q,const bf16*__restrict__ K,const bf16*__restrict__ V,bf16*O,const bf16*__restrict__ Gt,const float*__restrict__ cs0,float kmax,char*shm){
  int tid=threadIdx.x; asm volatile("":"+v"(tid)); const int lane=tid&63,r32=lane&31,hi=lane>>5; const int wid=__builtin_amdgcn_readfirstlane(tid>>6);
  const long rowbase=(long)b*SEQ; const int q0=qb*QB;
  const bf16*Qw=Q+(rowbase+q0+wid*QBLK)*DM+h*D;
  bf16x8 qr[4];
  #pragma unroll
  for(int d0=0;d0<4;++d0)qr[d0]=*reinterpret_cast<const bf16x8*>(&Qw[(long)r32*DM+d0*16+hi*8]);
  int t0;
  { typedef __attribute__((address_space(3))) float* lds_fptr; typedef __attribute__((address_space(3))) int* lds_iptr;
    lds_fptr misc=(lds_fptr)((lds_cptr)shm+LDS_MISC);
    float nq=0.f;
    #pragma unroll
    for(int d0=0;d0<4;++d0){
      #pragma unroll
      for(int j=0;j<8;++j){const float f=__uint_as_float(((unsigned)(unsigned short)qr[d0][j])<<16); nq+=f*f;}}
    {auto rr=__builtin_amdgcn_permlane32_swap(__float_as_uint(nq),__float_as_uint(nq),false,false);nq=__uint_as_float(rr[0])+__uint_as_float(rr[1]);}
    nq=fmaxf(nq,__int_as_float(__builtin_amdgcn_ds_swizzle(__float_as_int(nq),(16<<10)|0x1f))); nq=fmaxf(nq,__int_as_float(__builtin_amdgcn_ds_swizzle(__float_as_int(nq),(8<<10)|0x1f)));
    nq=fmaxf(nq,__int_as_float(__builtin_amdgcn_ds_swizzle(__float_as_int(nq),(4<<10)|0x1f))); nq=fmaxf(nq,__int_as_float(__builtin_amdgcn_ds_swizzle(__float_as_int(nq),(2<<10)|0x1f)));
    nq=fmaxf(nq,__int_as_float(__builtin_amdgcn_ds_swizzle(__float_as_int(nq),(1<<10)|0x1f)));
    if(lane==0)misc[wid]=nq;
    if(tid==0)((lds_iptr)misc)[8]=0;
    asm volatile("s_waitcnt vmcnt(0) lgkmcnt(0)\n\ts_barrier":::"memory");
    float q2=misc[0];
    #pragma unroll
    for(int w_=1;w_<NW;++w_)q2=fmaxf(q2,misc[w_]);
    const float thr=-45.f-2.f*sqrtf(q2)*kmax*1.0001f;
    const int NT0=(q0+QB)/KVBLK; const float cref0=cs0[q0];
    if(tid>=1&&2*tid<=NT0-4){ const float bb=(cref0-cs0[128*tid-1])*1.4426950408889634f; if(bb<=thr)atomicMax((int*)((lds_iptr)misc+8),2*tid); }
    asm volatile("s_waitcnt vmcnt(0) lgkmcnt(0)\n\ts_barrier":::"memory");
    t0=__builtin_amdgcn_readfirstlane(((lds_iptr)misc)[8]);
  }
  const float*cs=cs0+t0*KVBLK;
  const bf16*Kh=K+(rowbase+(long)t0*KVBLK)*DM+h*D,*Vh=V+(rowbase+(long)t0*KVBLK)*DM+h*D;
  const unsigned lds0=(unsigned)(uintptr_t)shm;
  float*wsf=(float*)(shm+LDS_WS)+wid*64;
  const bf16*ksrc=Kh+(long)lane*DM+wid*8;
  const bf16*vsrc=Vh+(long)(16*(wid&3)+(lane>>2))*DM+(wid>>2)*32+(lane&3)*8;
  const unsigned kdst=lds0+LDS_K+wid*1024, vdst=lds0+LDS_V+wid*1024;
  #define DMA_K(t,slot) glds16(ksrc+(long)(t)*KVBLK*DM,(unsigned)__builtin_amdgcn_readfirstlane(kdst+(slot)))
  #define DMA_V(t,slot) glds16(vsrc+(long)(t)*KVBLK*DM,(unsigned)__builtin_amdgcn_readfirstlane(vdst+(slot)))
  const int vb0=(int)(lds0+LDS_V)+((lane>>4)&1)*32+(lane&3)*8+(4*hi+((lane&15)>>2))*64;
  const char*Kbase=shm+LDS_K; bf16x8 kf[8];
  const lds_cptr shm3=(lds_cptr)shm; const lds_cptr kp0=shm3+LDS_K+hi*1024+r32*16; const lds_cptr vp0=shm3+LDS_V+((lane>>4)&1)*32+(lane&3)*8+(4*hi+((lane&15)>>2))*64;
  const int NT=(q0+QB)/KVBLK-t0;
  {
    typedef __attribute__((address_space(3))) float* lds_fptr; lds_fptr bt=(lds_fptr)((lds_cptr)shm+LDS_BETA);
    const float cref=cs0[q0]; const int nkv=NT*KVBLK;
    for(int s_=tid;s_<nkv;s_+=NW*64) bt[s_]=(cref-cs[s_])*1.4426950408889634f;
  }
  const lds_cptr bp0=(lds_cptr)shm+LDS_BETA+hi*16;
  #define LDB(P0,P1,t) do{ const lds_cptr bq_=bp0+(t)*256; _Pragma("unroll") for(int g_=0;g_<4;++g_){ \
      const f32x4_t u0_=*(const __attribute__((address_space(3))) f32x4_t*)(bq_+g_*32), u1_=*(const __attribute__((address_space(3))) f32x4_t*)(bq_+128+g_*32); \
      P0[4*g_]=u0_[0];P0[4*g_+1]=u0_[1];P0[4*g_+2]=u0_[2];P0[4*g_+3]=u0_[3]; P1[4*g_]=u1_[0];P1[4*g_+1]=u1_[1];P1[4*g_+2]=u1_[2];P1[4*g_+3]=u1_[3]; } }while(0)
  DMA_K(0,0);DMA_V(0,0);DMA_K(1,SLOTB);
  float mhat=0.f,l_reg=0.f;f32x16 o[2];o[0]=f32x16{};o[1]=f32x16{};f32x16 zero16=f32x16{};
  const int qrel=wid*QBLK+r32;
  #define CMASK(P0,P1,t) do{int jb_=(t)-(NT-4); if(jb_>=0)cmask(P0,P1,jb_,qrel,hi);}while(0)
  bool resc=false;
  #define START(P0,P1) do{ const float rm=rowmax(P0,P1); resc=false; \
    { const float dl=rm; mhat=fadd_s(mhat,dl); \
      _Pragma("unroll") for(int r=0;r<16;++r){P0[r]=fsub_s(P0[r],dl);P1[r]=fsub_s(P1[r],dl);} } \
    _Pragma("unroll") for(int r=0;r<16;++r)P0[r]=__builtin_amdgcn_exp2f(P0[r]); }while(0)
  #define RESC() do{ if(resc){ asm volatile("s_waitcnt lgkmcnt(0)":::"memory"); \
      _Pragma("unroll") for(int d_=0;d_<2;++d_) _Pragma("unroll") for(int r=0;r<16;++r)o[d_][r]*=wsf[crow(r,hi)]; } }while(0)
  f32x16 pA0,pA1,pB0,pB1;
  int sl_prev=0,sl_cur=0,sl_next=SLOTB;
  #define ROT() do{sl_prev=sl_cur;sl_cur=sl_next;sl_next=(sl_next==(NSLOT-1)*SLOTB)?0:sl_next+SLOTB;}while(0)
  DMA_K(2,2*SLOTB);
  WAIT_BAR(3);
  qkt(pA0,pA1,Kbase,qr,zero16,r32,hi);asm volatile("s_nop 15\n\ts_nop 7":"+v"(pA0),"+v"(pA1));
  { LDB(pB0,pB1,0); _Pragma("unroll") for(int r=0;r<16;++r){pA0[r]+=pB0[r];pA1[r]+=pB1[r];} }
  CMASK(pA0,pA1,0);
  START(pA0,pA1);
  _Pragma("unroll") for(int r=0;r<16;++r)pA1[r]=__builtin_amdgcn_exp2f(pA1[r]);
  LDB(pB0,pB1,1);
  WAIT_BAR(0);
  DMA_K(3,0);DMA_V(1,SLOTB);
  ROT();
  kload8(kf,kp0+sl_cur);
  WAIT_BAR(2);
  s16x4 vlo[8],vhi[8]; u32x4 pw0,pw1,pw2,pw3;
  #define PKW(P,B) cvtpk_s(P[B],P[B+1])
  #define PAF(k) __builtin_bit_cast(bf16x8,pw##k)
  #define VFR(i) (bf16x8){vlo[i][0],vlo[i][1],vlo[i][2],vlo[i][3],vhi[i][0],vhi[i][1],vhi[i][2],vhi[i][3]}
  #define PIN(x) asm volatile("":"+v"(x))
  #define MX3(a,b,c) __builtin_fmaxf(__builtin_fmaxf((a),(b)),(c))
  #define GAPA(MF,A0,A1,A2,A3,W0,W1,PW) do{ MF; sacc+=A0; sacc+=A1; sacc+=A2; sacc+=A3; PIN(sacc); W0; W1; PIN(PW); SBAR(); }while(0)
  #define EX(v) __builtin_amdgcn_exp2f(v)
  #define GAPB(MF,X,B) do{ MF; X[B]=EX(X[B]); X[B+1]=EX(X[B+1]); X[B+2]=EX(X[B+2]); X[B+3]=EX(X[B+3]); PIN(X); SBAR(); }while(0)
  #define VRD(i) do{ vlo[i]=vtr(vp_+(((i)>>2)*4096+((i)&3)*1024)); vhi[i]=vtr(vp_+(((i)>>2)*4096+((i)&3)*1024+512)); }while(0)
  #define KRD(G,j) do{ if(G){ kload2(kf,kp0+sl_next,j); SBAR(); } }while(0)
  #define STEP(C0,C1,P0,P1,t,GK,GV,GL) do{ SBAR(); \
    const lds_cptr vp_=vp0+sl_prev; \
    _Pragma("unroll") for(int r=0;r<16;++r){C0[r]-=mhat;C1[r]-=mhat;} \
    VRD(0); SBAR(); float sacc=(P0[0]+P0[1]); \
    GAPA(C0=__builtin_amdgcn_mfma_f32_32x32x16_bf16(kf[0],qr[0],C0,0,0,0), P0[2],P0[3],P0[4],P0[5],     pw0[0]=PKW(P0,0), pw0[1]=PKW(P0,2), pw0); \
    VRD(4); SBAR(); GAPA(C1=__builtin_amdgcn_mfma_f32_32x32x16_bf16(kf[1],qr[0],C1,0,0,0), P0[6],P0[7],P0[8],P0[9],     pw0[2]=PKW(P0,4), pw0[3]=PKW(P0,6), pw0); \
    VRD(1); SBAR(); GAPA(C0=__builtin_amdgcn_mfma_f32_32x32x16_bf16(kf[2],qr[1],C0,0,0,0),   P0[10],P0[11],P0[12],P0[13], pw1[0]=PKW(P0,8), pw1[1]=PKW(P0,10), pw1); \
    VRD(5); SBAR(); GAPA(C1=__builtin_amdgcn_mfma_f32_32x32x16_bf16(kf[3],qr[1],C1,0,0,0),   P0[14],P0[15],P1[0],P1[1],   pw1[2]=PKW(P0,12),pw1[3]=PKW(P0,14), pw1); \
    VRD(2); SBAR(); GAPA(C0=__builtin_amdgcn_mfma_f32_32x32x16_bf16(kf[4],qr[2],C0,0,0,0),   P1[2],P1[3],P1[4],P1[5],     pw2[0]=PKW(P1,0), pw2[1]=PKW(P1,2), pw2); \
    VRD(6); SBAR(); GAPA(C1=__builtin_amdgcn_mfma_f32_32x32x16_bf16(kf[5],qr[2],C1,0,0,0),   P1[6],P1[7],P1[8],P1[9],     pw2[2]=PKW(P1,4), pw2[3]=PKW(P1,6), pw2); \
    VRD(3); SBAR(); GAPA(C0=__builtin_amdgcn_mfma_f32_32x32x16_bf16(kf[6],qr[3],C0,0,0,0),   P1[10],P1[11],P1[12],P1[13], pw3[0]=PKW(P1,8), pw3[1]=PKW(P1,10), pw3); \
    VRD(7); SBAR(); GAPA(C1=__builtin_amdgcn_mfma_f32_32x32x16_bf16(kf[7],qr[3],C1,0,0,0),   P1[14],P1[15],0.f,0.f,       pw3[2]=PKW(P1,12),pw3[3]=PKW(P1,14), pw3); \
    l_reg+=sacc; \
    if(GV){LDB(P0,P1,(t)+1);} \
    if(GK){DMA_K((t)+3,sl_cur);} if(GV){DMA_V((t)+1,sl_next);} \
    CMASK(C0,C1,t); \
    { float a=MX3(C0[0],C0[1],C1[0]),b=MX3(C0[2],C0[3],C1[1]); a=MX3(a,C1[2],C1[3]); \
      _Pragma("unroll") for(int r=4;r<16;r+=4){a=MX3(a,C0[r],C0[r+1]);b=MX3(b,C0[r+2],C0[r+3]);a=MX3(a,C1[r],C1[r+1]);b=MX3(b,C1[r+2],C1[r+3]);} \
      float rm=__builtin_fmaxf(a,b); { auto rr=__builtin_amdgcn_permlane32_swap(__float_as_uint(rm),__float_as_uint(rm),false,false); rm=__builtin_fmaxf(__uint_as_float(rr[0]),__uint_as_float(rr[1])); } \
      resc=false; \
      if(__builtin_expect(__any(rm>(float)THRL),0)){ const float dl=__builtin_fmaxf(rm,0.f); mhat+=dl; \
        _Pragma("unroll") for(int r=0;r<16;++r){C0[r]-=dl;C1[r]-=dl;} \
        const float f=__builtin_amdgcn_exp2f(-dl); l_reg*=f; if(hi==0)wsf[r32]=f; resc=true; } } \
    SBAR(); \
    GAPB(o[0]=__builtin_amdgcn_mfma_f32_32x32x16_bf16(PAF(0),VFR(0),o[0],0,0,0), C0,0); \
    GAPB(o[1]=__builtin_amdgcn_mfma_f32_32x32x16_bf16(PAF(0),VFR(4),o[1],0,0,0), C0,4); \
    KRD(GL,0); GAPB(o[0]=__builtin_amdgcn_mfma_f32_32x32x16_bf16(PAF(1),VFR(1),o[0],0,0,0), C0,8); \
    KRD(GL,1); GAPB(o[1]=__builtin_amdgcn_mfma_f32_32x32x16_bf16(PAF(1),VFR(5),o[1],0,0,0), C0,12); \
    KRD(GL,2); GAPB(o[0]=__builtin_amdgcn_mfma_f32_32x32x16_bf16(PAF(2),VFR(2),o[0],0,0,0), C1,0); \
    KRD(GL,3); GAPB(o[1]=__builtin_amdgcn_mfma_f32_32x32x16_bf16(PAF(2),VFR(6),o[1],0,0,0), C1,4); \
    GAPB(o[0]=__builtin_amdgcn_mfma_f32_32x32x16_bf16(PAF(3),VFR(3),o[0],0,0,0), C1,8); \
    GAPB(o[1]=__builtin_amdgcn_mfma_f32_32x32x16_bf16(PAF(3),VFR(7),o[1],0,0,0), C1,12); \
    }while(0)
  int t=1;
  #undef CMASK
  #define CMASK(P0,P1,t) do{}while(0)
  for(;t+5<NT;t+=2){
    STEP(pB0,pB1,pA0,pA1,t,true,true,true);     WAIT_BAR(2); RESC(); ROT();
    STEP(pA0,pA1,pB0,pB1,t+1,true,true,true);   WAIT_BAR(2); RESC(); ROT();
  }
  #undef CMASK
  #define CMASK(P0,P1,t) do{int jb_=(t)-(NT-4); if(jb_>=0)cmask(P0,P1,jb_,qrel,hi);}while(0)
  #define ENDW(tt) do{ if((tt)+3<NT){WAIT_BAR(2);} else if((tt)+2<NT){WAIT_BAR(1);} else {WAIT_BAR(0);} }while(0)
  for(;t+1<NT;t+=2){
    STEP(pB0,pB1,pA0,pA1,t,(t+3<NT),(t+1<NT),(t+1<NT));       ENDW(t);   RESC(); ROT();
    STEP(pA0,pA1,pB0,pB1,t+1,(t+4<NT),(t+2<NT),(t+2<NT));     ENDW(t+1); RESC(); ROT();
  }
  STEP(pB0,pB1,pA0,pA1,NT-1,false,false,false); RESC();
  { float sacc=pB0[0]+pB0[1]; _Pragma("unroll") for(int r=2;r<16;++r)sacc+=pB0[r]; _Pragma("unroll") for(int r=0;r<16;++r)sacc+=pB1[r]; l_reg+=sacc;
    pw0=(u32x4){PKW(pB0,0),PKW(pB0,2),PKW(pB0,4),PKW(pB0,6)};pw1=(u32x4){PKW(pB0,8),PKW(pB0,10),PKW(pB0,12),PKW(pB0,14)};pw2=(u32x4){PKW(pB1,0),PKW(pB1,2),PKW(pB1,4),PKW(pB1,6)};pw3=(u32x4){PKW(pB1,8),PKW(pB1,10),PKW(pB1,12),PKW(pB1,14)};
    SBAR(); pv(o,vb0+sl_cur,PAF(0),PAF(1),PAF(2),PAF(3)); }
  #undef PKW
  #undef PAF
  #undef VFR
  #undef PIN
  #undef MX3
  #undef GAPA
  #undef GAPB
  #undef EX
  #undef VRD
  #undef KRD
  #undef STEP
  #undef ENDW
  {auto rr=__builtin_amdgcn_permlane32_swap(__float_as_uint(l_reg),__float_as_uint(l_reg),false,false);l_reg=__uint_as_float(rr[0])+__uint_as_float(rr[1]);}
  if(hi==0)wsf[32+r32]=l_reg;asm volatile("s_waitcnt lgkmcnt(0)":::"memory");
  float rli[16];
  #pragma unroll
  for(int r=0;r<16;++r)rli[r]=__builtin_amdgcn_rcpf(wsf[32+crow(r,hi)]);
  bf16*Ow=O+(rowbase+q0+wid*QBLK)*DM+h*D;
  { bf16*stg=(bf16*)(shm+LDS_OST)+wid*2048;
    #pragma unroll
    for(int r=0;r<16;++r){const int orow=crow(r,hi);
      #pragma unroll
      for(int d0=0;d0<2;++d0)stg[orow*64+d0*32+r32]=__float2bfloat16(o[d0][r]*rli[r]);}
    asm volatile("s_waitcnt lgkmcnt(0)":::"memory");
    const bf16*Gw=Gt+(rowbase+q0+wid*QBLK)*DM+h*D;
    #pragma unroll
    for(int i=0;i<4;++i){const int row=i*8+(lane>>3),ch=lane&7; u32x4 v=*(const u32x4*)(stg+row*64+ch*8); const u32x4 gq=*(const u32x4*)(Gw+(long)row*DM+ch*8);
      #pragma unroll
      for(int e=0;e<4;++e){ const float o0=__uint_as_float(v[e]<<16),o1=__uint_as_float(v[e]&0xffff0000u),g0=__uint_as_float(gq[e]<<16),g1=__uint_as_float(gq[e]&0xffff0000u);
        const float s0=__builtin_amdgcn_rcpf(1.f+__builtin_amdgcn_exp2f(-1.4426950408889634f*g0)),s1=__builtin_amdgcn_rcpf(1.f+__builtin_amdgcn_exp2f(-1.4426950408889634f*g1));
        v[e]=cvtpk_s(o0*s0,o1*s1); }
      ATTN_STORE16(Ow+(long)row*DM+ch*8,v);} }
  asm volatile("s_waitcnt lgkmcnt(0)\n\ts_barrier":::"memory");
  #undef DMA_K
  #undef DMA_V
  #undef LDB
  #undef CMASK
  #undef START
  #undef RESC
  #undef ROT
}
constexpr int ATTN_LDS_BYTES=LDS_BYTES;
struct AttnTensors { const bf16* Q; const bf16* K; const bf16* V; bf16* O; const bf16* G; const float* C; float kmax; };
struct AttnUnit { int bh; int qb; };
struct StaticOrder {
  int vcu,G;
  __device__ __forceinline__ explicit StaticOrder(int grid,int block):vcu((grid%8==0)?(block%8)*(grid/8)+block/8:block),G(grid){}
  __device__ __forceinline__ bool next(int i,AttnUnit&u)const{
    if(G==256){ if(i>=8)return false; const int s=vcu&7; u.bh=vcu>>3; const int qi=i*8+((i&1)?7-s:s); u.qb=NQB-1-qi; return true; }
    const int L=i*G+vcu; if(L>=BATCH*NHEAD*NQB)return false; u.bh=L%(BATCH*NHEAD); u.qb=NQB-1-L/(BATCH*NHEAD); return true; }
  __device__ __forceinline__ void a_ready(const AttnUnit&)const{}
  __device__ __forceinline__ void done(const AttnUnit&)const{}
};
template<class Sched,int THRL=8> __device__ __forceinline__ void attn_phase(char*lds,const AttnTensors&T,const Sched&S){
  AttnUnit u;
  for(int i=0;S.next(i,u);++i){ S.a_ready(u); attn_unit<THRL>(u.bh/NHEAD,u.bh%NHEAD,u.qb,T.Q,T.K,T.V,T.O,T.G,T.C+(long)u.bh*SEQ,T.kmax,lds); S.done(u); }
}
#undef SBAR
#undef WAIT_BAR
}
#ifndef PG8_SP2
#define PG8_SP2 true
#endif
#ifndef PG8_ALIGN
#define PG8_ALIGN true
#endif
constexpr int NWAVES = 8;
constexpr int SEQL = 16384, NB = 2, M = NB * SEQL, D = 1024, FF = 2816, PLE = 256, DEPTH = 4;
constexpr int GLA_IN = 3088, GLA_INP = 3328, KVF_N = 2064, KVF_NP = 2304;
constexpr int NCH = SEQL / 64;
constexpr float LN_EPS = 1e-5f;
constexpr float DN_ALPHA = 1.681792830507429f;
constexpr size_t MiB = 1u << 20;
constexpr size_t WS_W = 1 * MiB, WS_XB = 50 * MiB, WS_AR = 114 * MiB, WS_END = (114 + 476) * MiB;
constexpr size_t OW_F1IN = 0, OW_F1OUT = 5767168, OW_F2IN = 8650752, OW_F2OUT = 14417920, OW_PG = 17301504, OW_PP = 18350080, OW_MIXIN = 18612224, OW_MIXO = 22020096, OW_KVF = 23068672;
constexpr size_t AR_H = 0, AR_PB = 176 * MiB, AR_PLE = 280 * MiB, AR_KSH = 344 * MiB, AR_VSH = 408 * MiB, AR_CSH = 472 * MiB, AR_FLOG = 474 * MiB;
constexpr size_t AR_GQ = 0, AR_GK = 32 * MiB, AR_GV = 64 * MiB, AR_GR = 128 * MiB, AR_GA = 192 * MiB, AR_GD = 194 * MiB, AR_GKT = 196 * MiB, AR_GVT = 228 * MiB, AR_GST = 292 * MiB;
constexpr size_t AR_FQ = 0, AR_FG = 64 * MiB;
constexpr int LDS_BYTES = 150016;
static_assert(attn_body::ATTN_LDS_BYTES <= LDS_BYTES && pg8::STAGE_BYTES <= LDS_BYTES, "LDS map");

#define LAS __attribute__((address_space(3)))
typedef unsigned short bf16;
typedef unsigned v4u __attribute__((ext_vector_type(4)));
typedef unsigned v2u __attribute__((ext_vector_type(2)));
typedef float f32x4 __attribute__((ext_vector_type(4)));
typedef float f32x16 __attribute__((ext_vector_type(16)));
typedef short bf16x8 __attribute__((ext_vector_type(8)));
typedef short bf16x4 __attribute__((ext_vector_type(4)));
#define LDS_WAIT() asm volatile("s_waitcnt lgkmcnt(0)" ::: "memory")
__device__ __forceinline__ unsigned pk2(float lo, float hi) { typedef float f2 __attribute__((ext_vector_type(2))); typedef __bf16 b2 __attribute__((ext_vector_type(2))); f2 v = {lo, hi}; b2 b = __builtin_convertvector(v, b2); return __builtin_bit_cast(unsigned, b); }
__device__ __forceinline__ float bflo(unsigned w) { return __uint_as_float(w << 16); }
__device__ __forceinline__ float bfhi(unsigned w) { return __uint_as_float(w & 0xffff0000u); }
template <int O> __device__ __forceinline__ float swz_xor(float v) { return __int_as_float(__builtin_amdgcn_ds_swizzle(__float_as_int(v), (O << 10) | 0x1f)); }
__device__ __forceinline__ float half_sum(float v) { auto rr = __builtin_amdgcn_permlane32_swap(__float_as_uint(v), __float_as_uint(v), false, false); return __uint_as_float(rr[0]) + __uint_as_float(rr[1]); }
__device__ __forceinline__ float half_max(float v) { auto rr = __builtin_amdgcn_permlane32_swap(__float_as_uint(v), __float_as_uint(v), false, false); return fmaxf(__uint_as_float(rr[0]), __uint_as_float(rr[1])); }
__device__ __forceinline__ float wave_sum(float v) { v += swz_xor<1>(v); v += swz_xor<2>(v); v += swz_xor<4>(v); v += swz_xor<8>(v); v += swz_xor<16>(v); return half_sum(v); }
__device__ __forceinline__ float wave_max(float v) { v = fmaxf(v, swz_xor<1>(v)); v = fmaxf(v, swz_xor<2>(v)); v = fmaxf(v, swz_xor<4>(v)); v = fmaxf(v, swz_xor<8>(v)); v = fmaxf(v, swz_xor<16>(v)); return half_max(v); }

struct Args { const float* in[24]; float* out; unsigned char* ws; };

struct Frame {
    unsigned char* lds; unsigned char* ws; unsigned char* ar;
    int tid, lane, wave, G, gw, NGW, bx;
};

__device__ __forceinline__ void tr_item(const float* __restrict__ W, int K, int N, int nblk, bf16* __restrict__ WT, int mode, float* scr, int item, int lane) {
    const int kb = item / nblk, nb = item % nblk, k0 = 64 * kb, n0 = 32 * nb;
    const int nn = n0 + (lane & 31); const bool ok = nn < N;
#pragma unroll 8
    for (int i = 0; i < 32; ++i) { const int kk = 2 * i + (lane >> 5); scr[kk * 33 + (lane & 31)] = ok ? W[(size_t)(k0 + kk) * N + nn] : 0.f; }
    LDS_WAIT();
    const int c = lane & 7;
#pragma unroll
    for (int j = 0; j < 4; ++j) { const int n = (lane >> 3) + 8 * j; const float* s = scr + (8 * c) * 33 + n;
        v4u o; o.x = pk2(s[0 * 33], s[1 * 33]); o.y = pk2(s[2 * 33], s[3 * 33]); o.z = pk2(s[4 * 33], s[5 * 33]); o.w = pk2(s[6 * 33], s[7 * 33]);
        const int gn = n0 + n; int drow = gn;
        if (mode) drow = (gn < FF) ? (gn / 128) * 256 + (gn % 128) : ((gn - FF) / 128) * 256 + 128 + ((gn - FF) % 128);
        *(v4u*)(WT + (size_t)drow * K + k0 + 8 * c) = o; }
    LDS_WAIT();
}
__device__ __forceinline__ void convert_weights(const Frame& F, const float* w_f1in, const float* w_f2in, const float* w_f1out, const float* w_f2out, const float* w_pg, const float* w_pp, const float* w_glain, const float* w_foxin, const float* w_glao, const float* w_foxo, const float* w_kvf, int L, bool with_kvf) {
    float* scr = (float*)(F.lds + F.wave * 16384);
    bf16* Wb = (bf16*)(F.ws + WS_W);
    const int I0 = 16 * 176, I1 = 44 * 32, I4 = 16 * 32, I5 = 4 * 32, I6 = (L < 2) ? 16 * (GLA_INP / 32) : 16 * 64, I7 = 16 * 32, I8 = with_kvf ? 16 * (KVF_NP / 32) : 0;
    const int NIT = 2 * I0 + 2 * I1 + I4 + I5 + I6 + I7 + I8;
    for (int it = F.gw; it < NIT; it += F.NGW) {
        int r = it;
        if (r < I0) { tr_item(w_f1in + (size_t)L * D * 2 * FF, D, 2 * FF, 176, Wb + OW_F1IN, 1, scr, r, F.lane); continue; } r -= I0;
        if (r < I0) { tr_item(w_f2in + (size_t)L * D * 2 * FF, D, 2 * FF, 176, Wb + OW_F2IN, 1, scr, r, F.lane); continue; } r -= I0;
        if (r < I1) { tr_item(w_f1out + (size_t)L * FF * D, FF, D, 32, Wb + OW_F1OUT, 0, scr, r, F.lane); continue; } r -= I1;
        if (r < I1) { tr_item(w_f2out + (size_t)L * FF * D, FF, D, 32, Wb + OW_F2OUT, 0, scr, r, F.lane); continue; } r -= I1;
        if (r < I4) { tr_item(w_pg + (size_t)L * D * D, D, D, 32, Wb + OW_PG, 0, scr, r, F.lane); continue; } r -= I4;
        if (r < I5) { tr_item(w_pp + (size_t)L * PLE * D, PLE, D, 32, Wb + OW_PP, 0, scr, r, F.lane); continue; } r -= I5;
        if (r < I6) { if (L < 2) tr_item(w_glain + (size_t)L * D * GLA_IN, D, GLA_IN, GLA_INP / 32, Wb + OW_MIXIN, 0, scr, r, F.lane);
                      else tr_item(w_foxin + (size_t)(L - 2) * D * 2048, D, 2048, 64, Wb + OW_MIXIN, 0, scr, r, F.lane); continue; } r -= I6;
        if (r < I7) { tr_item((L < 2) ? w_glao + (size_t)L * D * D : w_foxo + (size_t)(L - 2) * D * D, D, D, 32, Wb + OW_MIXO, 0, scr, r, F.lane); continue; } r -= I7;
        tr_item(w_kvf, D, KVF_N, KVF_NP / 32, Wb + OW_KVF, 0, scr, r, F.lane);
    }
}
__device__ __forceinline__ void cvt_rows(const Frame& F, const float* __restrict__ src, bf16* __restrict__ dst, size_t n) {
    const size_t nthr = (size_t)F.G * 512, t0 = (size_t)F.bx * 512 + F.tid;
    for (size_t i = t0 * 8; i < n; i += nthr * 8) {
        const f32x4 a = *(const f32x4*)(src + i), b = *(const f32x4*)(src + i + 4);
        v4u o; o.x = pk2(a[0], a[1]); o.y = pk2(a[2], a[3]); o.z = pk2(b[0], b[1]); o.w = pk2(b[2], b[3]);
        *(v4u*)(dst + i) = o;
    }
}
__device__ __forceinline__ void ln_phase(const Frame& F, const float* __restrict__ g, const float* __restrict__ bta, float* X, bf16* XB) {
    f32x4 gv[4], bv[4];
#pragma unroll
    for (int j = 0; j < 4; ++j) { gv[j] = ((const f32x4*)g)[F.lane + 64 * j]; bv[j] = ((const f32x4*)bta)[F.lane + 64 * j]; }
    for (int m = F.gw; m < M; m += F.NGW) {
        f32x4* xr = (f32x4*)(X + (size_t)m * D) + F.lane;
        f32x4 v[4]; float s = 0.f;
#pragma unroll
        for (int j = 0; j < 4; ++j) { v[j] = xr[64 * j]; s += (v[j][0] + v[j][1]) + (v[j][2] + v[j][3]); }
        const float mean = wave_sum(s) * (1.f / D); float s2 = 0.f;
#pragma unroll
        for (int j = 0; j < 4; ++j) { v[j] = v[j] - mean; s2 += (v[j][0] * v[j][0] + v[j][1] * v[j][1]) + (v[j][2] * v[j][2] + v[j][3] * v[j][3]); }
        const float rstd = 1.f / sqrtf(wave_sum(s2) * (1.f / D) + LN_EPS);
        v2u* o8 = (v2u*)(XB + (size_t)m * D) + F.lane;
#pragma unroll
        for (int j = 0; j < 4; ++j) { const f32x4 y = v[j] * rstd * gv[j] + bv[j]; xr[64 * j] = y; v2u w; w.x = pk2(y[0], y[1]); w.y = pk2(y[2], y[3]); o8[64 * j] = w; }
    }
}
__device__ __forceinline__ void cumsum_phase(const Frame& F, const float* __restrict__ flog, float* __restrict__ cs) {
    float* sh = (float*)F.lds;
    for (int u = F.bx; u < NB * 16; u += F.G) {
        const int b = u >> 4, h = u & 15; const float* src = flog + ((size_t)b * SEQL + (size_t)F.tid * 32) * 16 + h;
        float tot = 0.f;
#pragma unroll 8
        for (int i = 0; i < 32; ++i) tot += src[i * 16];
        __syncthreads();
        sh[F.tid] = tot;
        __syncthreads();
        float pre = 0.f;
        for (int i = 0; i < F.tid; ++i) pre += sh[i];
        float* dst = cs + (size_t)u * SEQL + F.tid * 32;
#pragma unroll 8
        for (int i = 0; i < 32; ++i) { pre += src[i * 16]; dst[i] = pre; }
    }
}
__device__ __forceinline__ void kmax_phase(const Frame& F, const bf16* __restrict__ KS, unsigned* cell) {
    float mx = 0.f;
    for (int m = F.gw; m < M; m += F.NGW) {
        const v4u a = *(const v4u*)(KS + (size_t)m * D + F.lane * 16), b = *(const v4u*)(KS + (size_t)m * D + F.lane * 16 + 8);
        float ss = 0.f;
#pragma unroll
        for (int e = 0; e < 4; ++e) { const float x0 = bflo(a[e]), x1 = bfhi(a[e]), y0 = bflo(b[e]), y1 = bfhi(b[e]); ss += x0 * x0 + x1 * x1 + y0 * y0 + y1 * y1; }
        ss += swz_xor<1>(ss); ss += swz_xor<2>(ss);
        mx = fmaxf(mx, ss);
    }
    mx = wave_max(mx);
    if (F.lane == 0) atomicMax(cell, __float_as_uint(mx));
}
__device__ __forceinline__ unsigned f2bf1(float x) { return pk2(x, 0.f) & 0xffffu; }
#define MFMA32(a, b, c) __builtin_amdgcn_mfma_f32_32x32x16_bf16((a), (b), (c), 0, 0, 0)
#define MFMA16(a, b, c) __builtin_amdgcn_mfma_f32_16x16x32_bf16((a), (b), (c), 0, 0, 0)
__device__ __forceinline__ void gla_prep(const Frame& F, const float* __restrict__ wa2, const float* __restrict__ ba) {
    bf16* GQ = (bf16*)(F.ar + AR_GQ); bf16* GK = (bf16*)(F.ar + AR_GK); const bf16* GV = (const bf16*)(F.ar + AR_GV); const float* GA = (const float*)(F.ar + AR_GA);
    float* GD = (float*)(F.ar + AR_GD); bf16* GKT = (bf16*)(F.ar + AR_GKT); bf16* GVT = (bf16*)(F.ar + AR_GVT);
    float* sa = (float*)F.lds; bf16* sv = (bf16*)(F.lds + 4096);
    const int j = F.tid;
    float w[16];
#pragma unroll
    for (int m = 0; m < 16; ++m) w[m] = wa2[m * 512 + j];
    const float bj = ba[j];
    for (int cu = F.bx; cu < NB * NCH; cu += F.G) {
        const size_t m0 = (size_t)cu * 64;
        __syncthreads();
        if (F.tid < 256) ((f32x4*)sa)[F.tid] = ((const f32x4*)(GA + m0 * 16))[F.tid];
        __syncthreads();
        float cum = 0.f; unsigned kt[32];
#pragma unroll
        for (int r = 0; r < 64; ++r) {
            const f32x4 a0 = ((const f32x4*)sa)[r * 4], a1 = ((const f32x4*)sa)[r * 4 + 1], a2 = ((const f32x4*)sa)[r * 4 + 2], a3 = ((const f32x4*)sa)[r * 4 + 3];
            float z = bj;
            z += a0[0] * w[0] + a0[1] * w[1] + a0[2] * w[2] + a0[3] * w[3];
            z += a1[0] * w[4] + a1[1] * w[5] + a1[2] * w[6] + a1[3] * w[7];
            z += a2[0] * w[8] + a2[1] * w[9] + a2[2] * w[10] + a2[3] * w[11];
            z += a3[0] * w[12] + a3[1] * w[13] + a3[2] * w[14] + a3[3] * w[15];
            cum += pg8::flogsig(z) * 0.0625f;
            const float e = __expf(cum), ei = __expf(-cum);
            const size_t o = (m0 + r) * 512 + j;
            GQ[o] = (bf16)f2bf1(bflo((unsigned)GQ[o]) * e);
            const unsigned kb = f2bf1(bflo((unsigned)GK[o]) * ei);
            GK[o] = (bf16)kb;
            if (r & 1) kt[r >> 1] |= kb << 16; else kt[r >> 1] = kb;
        }
        GD[(size_t)cu * 512 + j] = __expf(cum);
        v4u* kd = (v4u*)(GKT + ((size_t)cu * 512 + j) * 64);
#pragma unroll
        for (int i = 0; i < 8; ++i) { v4u t; t.x = kt[4 * i]; t.y = kt[4 * i + 1]; t.z = kt[4 * i + 2]; t.w = kt[4 * i + 3]; kd[i] = t; }
        for (int h = 0; h < 4; ++h) {
            __syncthreads();
#pragma unroll
            for (int i = 0; i < 4; ++i) { const int q = F.tid + 512 * i, row = q >> 5, cc = q & 31;
                *(v4u*)(sv + row * 264 + cc * 8) = *(const v4u*)(GV + (m0 + row) * 1024 + h * 256 + cc * 8); }
            __syncthreads();
            const int c = F.tid & 255, half = F.tid >> 8;
            unsigned vt[16];
#pragma unroll
            for (int s = 0; s < 16; ++s) vt[s] = (unsigned)sv[(half * 32 + 2 * s) * 264 + c] | ((unsigned)sv[(half * 32 + 2 * s + 1) * 264 + c] << 16);
            v4u* vd = (v4u*)(GVT + ((size_t)cu * 1024 + h * 256 + c) * 64 + half * 32);
#pragma unroll
            for (int i = 0; i < 4; ++i) { v4u t; t.x = vt[4 * i]; t.y = vt[4 * i + 1]; t.z = vt[4 * i + 2]; t.w = vt[4 * i + 3]; vd[i] = t; }
        }
    }
}
__device__ __forceinline__ void gla_scan(const Frame& F) {
    const bf16* GKT = (const bf16*)(F.ar + AR_GKT); const bf16* GVT = (const bf16*)(F.ar + AR_GVT); const float* GD = (const float*)(F.ar + AR_GD); bf16* GST = (bf16*)(F.ar + AR_GST);
    if (F.wave < 4) {
        const int l15 = F.lane & 15, l4 = F.lane >> 4;
        for (int wt = F.bx * 4 + F.wave; wt < 1024; wt += F.G * 4) {
            const int bh = wt >> 7, ib = (wt >> 4) & 7, cb = wt & 15, b = bh >> 2, h = bh & 3;
            const bf16* kp = GKT + ((size_t)b * NCH * 512 + h * 128 + ib * 16 + l15) * 64 + 8 * l4;
            const bf16* vp = GVT + ((size_t)b * NCH * 1024 + h * 256 + cb * 16 + l15) * 64 + 8 * l4;
            const float* dp = GD + (size_t)b * NCH * 512 + h * 128 + ib * 16 + 4 * l4;
            bf16* sp = GST + ((size_t)bh * NCH * 256 + cb * 16 + l15) * 128 + ib * 16 + 4 * l4;
            f32x4 S = {0.f, 0.f, 0.f, 0.f};
            bf16x8 ka[8][2], vb[8][2]; f32x4 dd[8];
#define SC_LOAD(u, n) do { ka[u][0] = *(const bf16x8*)(kp + (size_t)(n) * 32768); ka[u][1] = *(const bf16x8*)(kp + (size_t)(n) * 32768 + 32); \
                           vb[u][0] = *(const bf16x8*)(vp + (size_t)(n) * 65536); vb[u][1] = *(const bf16x8*)(vp + (size_t)(n) * 65536 + 32); \
                           dd[u] = *(const f32x4*)(dp + (size_t)(n) * 512); } while (0)
#pragma unroll
            for (int u = 0; u < 8; ++u) SC_LOAD(u, u);
            for (int n0 = 0; n0 < NCH; n0 += 8) {
#pragma unroll
                for (int u = 0; u < 8; ++u) {
                    const int n = n0 + u;
                    v2u st; st.x = pk2(S[0], S[1]); st.y = pk2(S[2], S[3]);
                    *(v2u*)(sp + (size_t)n * 32768) = st;
                    S = MFMA16(ka[u][0], vb[u][0], S); S = MFMA16(ka[u][1], vb[u][1], S);
                    S = S * dd[u];
                    if (n + 8 < NCH) SC_LOAD(u, n + 8);
                }
            }
#undef SC_LOAD
        }
    }
}
__device__ __forceinline__ void gla_out(const Frame& F, const float* __restrict__ gng, const float* __restrict__ gnb) {
    const bf16* GQ = (const bf16*)(F.ar + AR_GQ); const bf16* GK = (const bf16*)(F.ar + AR_GK); const bf16* GVT = (const bf16*)(F.ar + AR_GVT);
    const bf16* GST = (const bf16*)(F.ar + AR_GST); const bf16* GR = (const bf16*)(F.ar + AR_GR); bf16* OG = (bf16*)(F.ar + AR_GV);
    float* red = (float*)F.lds;
    const int lane = F.lane, r32 = lane & 31, hi = lane >> 5, w = F.wave;
    int par = 0;
    for (int uid = F.bx; uid < NB * NCH * 4; uid += F.G, par ^= 1) {
        const int cu = uid >> 2, h = uid & 3; const size_t m0 = (size_t)cu * 64;
        const int bh = (cu / NCH) * 4 + h, n = cu % NCH;
        f32x16 X00 = {}, X01 = {}, X11 = {};
        const bf16* qb = GQ + (m0 + r32) * 512 + h * 128 + 8 * hi;
        const bf16* kb = GK + (m0 + r32) * 512 + h * 128 + 8 * hi;
#pragma unroll
        for (int ks = 0; ks < 8; ++ks) {
            const bf16x8 q0 = *(const bf16x8*)(qb + ks * 16), q1 = *(const bf16x8*)(qb + 32 * 512 + ks * 16);
            const bf16x8 k0 = *(const bf16x8*)(kb + ks * 16), k1 = *(const bf16x8*)(kb + 32 * 512 + ks * 16);
            X00 = MFMA32(k0, q0, X00); X01 = MFMA32(k0, q1, X01); X11 = MFMA32(k1, q1, X11);
        }
#pragma unroll
        for (int reg = 0; reg < 16; ++reg) { const int sp = (reg & 3) + 8 * (reg >> 2) + 4 * hi; if (sp > r32) { X00[reg] = 0.f; X11[reg] = 0.f; } }
        bf16x8 B00[2], B01[2], B11[2];
#pragma unroll
        for (int sk = 0; sk < 2; ++sk) {
            v4u t;
            t.x = pk2(X00[8 * sk], X00[8 * sk + 1]); t.y = pk2(X00[8 * sk + 2], X00[8 * sk + 3]); t.z = pk2(X00[8 * sk + 4], X00[8 * sk + 5]); t.w = pk2(X00[8 * sk + 6], X00[8 * sk + 7]); B00[sk] = __builtin_bit_cast(bf16x8, t);
            t.x = pk2(X01[8 * sk], X01[8 * sk + 1]); t.y = pk2(X01[8 * sk + 2], X01[8 * sk + 3]); t.z = pk2(X01[8 * sk + 4], X01[8 * sk + 5]); t.w = pk2(X01[8 * sk + 6], X01[8 * sk + 7]); B01[sk] = __builtin_bit_cast(bf16x8, t);
            t.x = pk2(X11[8 * sk], X11[8 * sk + 1]); t.y = pk2(X11[8 * sk + 2], X11[8 * sk + 3]); t.z = pk2(X11[8 * sk + 4], X11[8 * sk + 5]); t.w = pk2(X11[8 * sk + 6], X11[8 * sk + 7]); B11[sk] = __builtin_bit_cast(bf16x8, t);
        }
        f32x16 o0 = {}, o1 = {};
        const bf16* vtp = GVT + ((size_t)cu * 1024 + h * 256 + 32 * w + r32) * 64 + 4 * hi;
#pragma unroll
        for (int stp = 0; stp < 2; ++stp)
#pragma unroll
            for (int sk = 0; sk < 2; ++sk) {
                const v2u lo = *(const v2u*)(vtp + 32 * stp + 16 * sk), hh = *(const v2u*)(vtp + 32 * stp + 16 * sk + 8);
                v4u t; t.x = lo.x; t.y = lo.y; t.z = hh.x; t.w = hh.y; const bf16x8 Av = __builtin_bit_cast(bf16x8, t);
                if (stp == 0) { o0 = MFMA32(Av, B00[sk], o0); o1 = MFMA32(Av, B01[sk], o1); } else { o1 = MFMA32(Av, B11[sk], o1); }
            }
        const bf16* stq = GST + (((size_t)bh * NCH + n) * 256 + 32 * w + r32) * 128 + 8 * hi;
#pragma unroll
        for (int ks = 0; ks < 8; ++ks) {
            const bf16x8 As = *(const bf16x8*)(stq + ks * 16);
            const bf16x8 q0 = *(const bf16x8*)(qb + ks * 16), q1 = *(const bf16x8*)(qb + 32 * 512 + ks * 16);
            o0 = MFMA32(As, q0, o0); o1 = MFMA32(As, q1, o1);
        }
        float s0 = 0.f, q0s = 0.f, s1 = 0.f, q1s = 0.f;
#pragma unroll
        for (int reg = 0; reg < 16; ++reg) { s0 += o0[reg]; q0s += o0[reg] * o0[reg]; s1 += o1[reg]; q1s += o1[reg] * o1[reg]; }
        s0 = half_sum(s0); q0s = half_sum(q0s); s1 = half_sum(s1); q1s = half_sum(q1s);
        if (hi == 0) { float* rp = red + ((par * 8 + w) * 64 + r32) * 2; rp[0] = s0; rp[1] = q0s; rp[64] = s1; rp[65] = q1s; }
        __syncthreads();
        float mean[2], rstd[2];
#pragma unroll
        for (int st = 0; st < 2; ++st) { float ts = 0.f, tq = 0.f;
#pragma unroll
            for (int ww = 0; ww < 8; ++ww) { const float* rp = red + ((par * 8 + ww) * 64 + 32 * st + r32) * 2; ts += rp[0]; tq += rp[1]; }
            mean[st] = ts * (1.f / 256.f); const float var = fmaxf(tq * (1.f / 256.f) - mean[st] * mean[st], 0.f); rstd[st] = 1.f / sqrtf(var + LN_EPS); }
#pragma unroll
        for (int st = 0; st < 2; ++st) {
            const size_t row = m0 + 32 * st + r32;
#pragma unroll
            for (int g = 0; g < 4; ++g) {
                const int gl = h * 256 + 32 * w + 8 * g + 4 * hi;
                const f32x4 gg = *(const f32x4*)(gng + gl), bb = *(const f32x4*)(gnb + gl);
                const v2u rr = *(const v2u*)(GR + row * 1024 + gl);
                const float rv[4] = {bflo(rr.x), bfhi(rr.x), bflo(rr.y), bfhi(rr.y)};
                float y[4];
#pragma unroll
                for (int jj = 0; jj < 4; ++jj) { const float ov = (st == 0) ? o0[4 * g + jj] : o1[4 * g + jj];
                    y[jj] = ((ov - mean[st]) * rstd[st] * gg[jj] + bb[jj]) * (rv[jj] * pg8::fsigmoid(rv[jj])); }
                v2u ow; ow.x = pk2(y[0], y[1]); ow.y = pk2(y[2], y[3]);
                *(v2u*)(OG + row * 1024 + gl) = ow;
            }
        }
    }
}
__global__ void __launch_bounds__(NWAVES * 64, 2) yoco_fwd(Args a) {
    extern __shared__ __attribute__((aligned(16))) unsigned char lds_raw[];
    cg::grid_group grid = cg::this_grid();
    Frame F;
    F.lds = lds_raw; F.ws = a.ws; F.ar = a.ws + WS_AR;
    F.tid = threadIdx.x; F.lane = F.tid & 63; F.wave = __builtin_amdgcn_readfirstlane(F.tid >> 6); F.bx = blockIdx.x;
    F.G = gridDim.x; F.gw = blockIdx.x * NWAVES + F.wave; F.NGW = F.G * NWAVES;
    {
        const float** const tab0 = (const float**)(a.ws + 64);
        if (F.tid == 0 && blockIdx.x == 0) {
            tab0[0] = a.in[0]; tab0[1] = a.in[1]; tab0[2] = a.in[2]; tab0[3] = a.in[3]; tab0[4] = a.in[4]; tab0[5] = a.in[5]; tab0[6] = a.in[6]; tab0[7] = a.in[7];
            tab0[8] = a.in[8]; tab0[9] = a.in[9]; tab0[10] = a.in[10]; tab0[11] = a.in[11]; tab0[12] = a.in[12]; tab0[13] = a.in[13]; tab0[14] = a.in[14]; tab0[15] = a.in[15];
            *(unsigned*)(a.ws + 1024) = 0u;
            tab0[16] = a.in[16]; tab0[17] = a.in[17]; tab0[18] = a.in[18]; tab0[19] = a.in[19]; tab0[20] = a.in[20]; tab0[21] = a.in[21]; tab0[22] = a.in[22]; tab0[23] = a.in[23];
        }
    }
#define TAB(i) (tab[(i)])
    convert_weights(F, a.in[2], a.in[18], a.in[3], a.in[19], a.in[20], a.in[21], a.in[6], a.in[14], a.in[11], a.in[15], a.in[12], 0, true);
    cvt_rows(F, a.in[0], (bf16*)(a.ws + WS_XB), (size_t)M * D);
    grid.sync();

    volatile int* const ctl = (volatile int*)(lds_raw + LDS_BYTES - 16);
    if (threadIdx.x == 0) ctl[0] = 0;
    __syncthreads();
    for (;;) {
        {
            const int step = __builtin_amdgcn_readfirstlane(ctl[0]);
            if (step >= 49) break;
            const int L = (step < 13) ? 0 : (step < 26 ? 1 : (step < 38 ? 2 : 3));
            const int st = step - ((L == 0) ? 0 : (L == 1 ? 13 : (L == 2 ? 26 : 38)));
            const unsigned long long prog = (L < 2) ? 0xCBA9876543210ull : (L == 2 ? 0xCBA987FE210Dull : 0xCBA987FE210ull);
            const int code = (int)((prog >> (4 * st)) & 15ull);
#define STEP_FRAME() \
            const unsigned char* ka = (const unsigned char*)__builtin_amdgcn_kernarg_segment_ptr(); \
            unsigned char* ws = *(unsigned char* const volatile*)(ka + 25 * 8); float* X = *(float* const volatile*)(ka + 24 * 8); \
            F.lds = lds_raw; F.ws = ws; F.ar = ws + WS_AR; \
            { int t_ = threadIdx.x, b_ = blockIdx.x, g_ = gridDim.x; asm volatile("" : "+v"(t_), "+s"(b_), "+s"(g_)); F.tid = t_; F.bx = b_; F.G = g_; } \
            F.lane = F.tid & 63; F.wave = __builtin_amdgcn_readfirstlane(F.tid >> 6); \
            F.gw = F.bx * NWAVES + F.wave; F.NGW = F.G * NWAVES; \
            LAS unsigned char* lds3 = (LAS unsigned char*)lds_raw; \
            const float** const tab = (const float**)(ws + 64); \
            bf16* const Wb = (bf16*)(ws + WS_W); bf16* const XB = (bf16*)(ws + WS_XB); bf16* const HB = (bf16*)(F.ar + AR_H); bf16* const PB = (bf16*)(F.ar + AR_PB); bf16* const PLEB = (bf16*)(F.ar + AR_PLE); \
            bf16* const KSH = (bf16*)(F.ar + AR_KSH); bf16* const VSH = (bf16*)(F.ar + AR_VSH); float* const CSH = (float*)(F.ar + AR_CSH); float* const FLOG = (float*)(F.ar + AR_FLOG); \
            (void)lds3; (void)tab; (void)Wb; (void)XB; (void)HB; (void)PB; (void)PLEB; (void)KSH; (void)VSH; (void)CSH; (void)FLOG; (void)X;
            switch (code) {
#ifndef NO_SWIGLU
            case 0: case 10: { STEP_FRAME()
#ifndef NO_PLE
                if (code == 10) {
                    pg8::Gemm g{XB, Wb + OW_PG, M, D, D}; pg8::StaticOrder S; S.init(M, D, F.G, F.bx);
                    pg8::EpiPle E{PLEB};
                    pg8::gemm_phase<pg8::EpiPle, pg8::StaticOrder, PG8_ALIGN, PG8_SP2>(lds3, g, S, E);
                }
#endif
                pg8::Gemm g{XB, Wb + (code == 0 ? OW_F1IN : OW_F2IN), M, 2 * FF, D}; pg8::StaticOrder S; S.init(M, 2 * FF, F.G, F.bx);
                pg8::EpiSwiGLU E{HB, FF};
                pg8::gemm_phase<pg8::EpiSwiGLU, pg8::StaticOrder, PG8_ALIGN, PG8_SP2>(lds3, g, S, E);
            } break;
#endif
#ifndef NO_RES
            case 1: case 7: case 11: { STEP_FRAME()
                const bf16* A = (code == 7) ? ((L < 2) ? (const bf16*)(F.ar + AR_GV) : (const bf16*)(F.ar + AR_FQ)) : HB;
                const bf16* Wt = Wb + (code == 1 ? OW_F1OUT : (code == 7 ? OW_MIXO : OW_F2OUT));
                const int K = (code == 7) ? D : FF;
                const float* base = (L == 0 && code == 1) ? TAB(0) : X;
                pg8::Gemm g{A, Wt, M, D, K}; pg8::StaticOrder S; S.init(M, D, F.G, F.bx);
                pg8::EpiRes E{base, X, (code == 11) ? PLEB : nullptr, DN_ALPHA, (code == 7) ? 1.f : 0.5f};
                pg8::gemm_phase<pg8::EpiRes, pg8::StaticOrder, PG8_ALIGN, PG8_SP2>(lds3, g, S, E);
            } break;
#endif
#ifndef NO_LN
            case 2: case 8: case 12: { STEP_FRAME()
                const int gi = (code == 2) ? 4 : (code == 8 ? 16 : 22);
                ln_phase(F, TAB(gi) + L * D, TAB(gi + 1) + L * D, X, XB);
                if (code == 2 && L == 2) { cumsum_phase(F, FLOG, CSH); kmax_phase(F, KSH, (unsigned*)(ws + 1024)); }
                if (code == 8) cvt_rows(F, TAB(1) + (size_t)L * M * PLE, PB, (size_t)M * PLE);
                if (code == 12 && L + 1 < DEPTH) convert_weights(F, TAB(2), TAB(18), TAB(3), TAB(19), TAB(20), TAB(21), TAB(6), TAB(14), TAB(11), TAB(15), TAB(12), L + 1, false);
            } break;
#endif
#ifndef NO_SPLIT
            case 3: case 9: case 13: case 14: { STEP_FRAME()
                const int mode = (code == 3) ? 0 : (code == 9 ? 1 : (code == 13 ? 2 : 3));
                const pg8::Gemm g{(code == 9) ? PB : XB, Wb + (code == 9 ? OW_PP : (code == 13 ? OW_KVF : OW_MIXIN)), M, (code == 3) ? GLA_INP : (code == 9 ? D : (code == 13 ? KVF_NP : 2048)), (code == 9) ? PLE : D};
                const pg8::EpiSplit E{F.ar, mode, TAB(13)};
                pg8::StaticOrder S; S.init(g.M, g.N, F.G, F.bx);
                pg8::gemm_phase<pg8::EpiSplit, pg8::StaticOrder, PG8_ALIGN, PG8_SP2>(lds3, g, S, E);
            } break;
#endif
#ifndef NO_PREP
            case 4: { STEP_FRAME() gla_prep(F, TAB(7) + (size_t)L * 16 * 512, TAB(8) + L * 512); } break;
#endif
#ifndef NO_SCAN
            case 5: { STEP_FRAME() gla_scan(F); } break;
#endif
#ifndef NO_OUT
            case 6: { STEP_FRAME() gla_out(F, TAB(9) + L * D, TAB(10) + L * D); } break;
#endif
#ifndef NO_ATTN
            case 15: { STEP_FRAME()
                const attn_body::AttnTensors AT{(const attn_body::bf16*)(F.ar + AR_FQ), (const attn_body::bf16*)KSH, (const attn_body::bf16*)VSH, (attn_body::bf16*)(F.ar + AR_FQ),
                                                (const attn_body::bf16*)(F.ar + AR_FG), CSH, sqrtf(*(const float*)(ws + 1024))};
                const attn_body::StaticOrder S((int)F.G, F.bx);
                attn_body::attn_phase<attn_body::StaticOrder>((char*)lds_raw, AT, S);
            } break;
#endif
            default: break;
            }
        }
        if (threadIdx.x == 0) ctl[0] = ctl[0] + 1;
        grid.sync();
    }
}

extern "C" void kernel_launch(void* const* d_in, const int* in_sizes, int n_in, void* d_out, int out_size, void* d_ws, size_t ws_size, hipStream_t stream) {
    static int grid = 0;
    if (grid == 0) {
        if (n_in != 24 || out_size != M * D || ws_size < WS_END) { fprintf(stderr, "kernel_launch: unexpected shapes (n_in %d, out %d, ws %zu)\n", n_in, out_size, ws_size); grid = -1; return; }
        int dev = 0, cus = 0, per_cu = 0;
        if (hipGetDevice(&dev) != hipSuccess || hipDeviceGetAttribute(&cus, hipDeviceAttributeMultiprocessorCount, dev) != hipSuccess) { grid = -1; return; }
        if (hipFuncSetAttribute((const void*)yoco_fwd, hipFuncAttributeMaxDynamicSharedMemorySize, LDS_BYTES) != hipSuccess) { fprintf(stderr, "kernel_launch: hipFuncSetAttribute failed\n"); grid = -1; return; }
        if (hipOccupancyMaxActiveBlocksPerMultiprocessor(&per_cu, (const void*)yoco_fwd, NWAVES * 64, LDS_BYTES) != hipSuccess || per_cu < 1) per_cu = 1;
        (void)hipGetLastError();
        grid = cus * per_cu;
    }
    if (grid < 0) return;
    Args a{};
    for (int i = 0; i < 24; ++i) a.in[i] = (const float*)d_in[i];
    a.out = (float*)d_out; a.ws = (unsigned char*)d_ws;
    void* args[] = {&a};
    const hipError_t e = hipLaunchCooperativeKernel((const void*)yoco_fwd, dim3(grid), dim3(NWAVES * 64), args, LDS_BYTES, stream);
    if (e != hipSuccess) fprintf(stderr, "kernel_launch: cooperative launch failed: %s (grid %d)\n", hipGetErrorString(e), grid);
}
```

```cpp
#include <hip/hip_runtime.h>
#include <hip/hip_cooperative_groups.h>
#include <cstdio>
#include <cstdint>
namespace cg = cooperative_groups;
namespace pg8 {
#define PG8_LAS __attribute__((address_space(3)))
typedef unsigned short bf16_t;
typedef short bf16x8 __attribute__((ext_vector_type(8)));
typedef float f32x4 __attribute__((ext_vector_type(4)));
typedef unsigned u32x4 __attribute__((ext_vector_type(4)));
constexpr int BM = 256, BK = 64, HALF = 128, HTB = HALF * BK * 2  , STAGE_BYTES = 8 * HTB, NXCD = 8, WGM = 8;

__host__ __device__ __forceinline__ int lds_byte(int r, int c) { const int st = (r >> 4) * 2 + (c >> 5), rr = r & 15, cc = c & 31, ob = rr * 64 + cc * 2; return st * 1024 + (ob ^ (((ob >> 9) & 1) << 5)); }
__host__ __device__ __forceinline__ void stage_rc(int b, int& R, int& C) { const int st = b / 1024, sb = b % 1024, swz = sb ^ (((sb >> 9) & 1) << 5); R = (st >> 1) * 16 + swz / 64; C = (st & 1) * 32 + (swz % 64) / 2; }
__host__ __device__ __forceinline__ int perm32(int rho) { const int n = rho >> 4, i = rho & 15; return 8 * (i >> 2) + 4 * n + (i & 3); }

struct Unit { int pm, pn; };
struct Gemm { const bf16_t* A; const bf16_t* Bt; int M, N, K; };

struct StaticOrder {
    int nM, nN, nwg, G, c;
    __host__ __device__ void init(int M, int N, int G_, int c_) { nM = M / BM; nN = N / BM; nwg = nM * nN; G = G_; c = c_; }
    __host__ __device__ bool next(int i, Unit& u) const {
        const long L = (long)i * G + c; if (L >= nwg) return false;
        int wgid = (int)L; { const int q = nwg / NXCD, r = nwg % NXCD, xcd = wgid % NXCD, off = wgid / NXCD; wgid = (xcd < r ? xcd * (q + 1) : r * (q + 1) + (xcd - r) * q) + off; }
        const int nig = WGM * nN, gid = wgid / nig, fm = gid * WGM, gsz = (nM - fm) < WGM ? (nM - fm) : WGM;
        u.pm = fm + ((wgid % nig) % gsz); u.pn = (wgid % nig) / gsz; return true;
    }
    __device__ __forceinline__ void a_ready(const Unit&) const {}
    __device__ __forceinline__ void done(const Unit&) const {}
};

__device__ __forceinline__ unsigned cvt_pk_bf16(float lo, float hi) { unsigned r; asm volatile("v_cvt_pk_bf16_f32 %0, %1, %2" : "=v"(r) : "v"(lo), "v"(hi)); return r; }
__device__ __forceinline__ float fsigmoid(float x) { return __builtin_amdgcn_rcpf(1.f + __builtin_amdgcn_exp2f(-1.4426950408889634f * x)); }
__device__ __forceinline__ float bf_lo(unsigned w) { return __uint_as_float(w << 16); }
__device__ __forceinline__ float bf_hi(unsigned w) { return __uint_as_float(w & 0xffff0000u); }
__device__ __forceinline__ float flogsig(float z) { return fminf(z, 0.f) - __logf(1.f + __expf(-fabsf(z))); }
typedef unsigned u32x2 __attribute__((ext_vector_type(2)));
#define EPI_IDS() { int t_ = threadIdx.x; asm volatile("" : "+v"(t_)); const int l_ = t_ & 63, w_ = __builtin_amdgcn_readfirstlane(t_ >> 6); wr = w_ >> 2; wc = w_ & 3; fr = l_ & 15; fq = l_ >> 4; }


struct EpiSwiGLU {
    static constexpr bool PERM = true, AFTER_DRAIN = false;
    bf16_t* H; int ldh;
    __device__ __forceinline__ void operator()(const f32x4 (&acc)[2][2][4][2], const Unit& u, int wr, int wc, int fr, int fq) const {
        EPI_IDS();
        const int row0 = u.pm * BM + wr * 64 + fr, col0 = u.pn * HALF + wc * 32 + 8 * fq;
#pragma unroll
        for (int ai = 0; ai < 2; ++ai)
#pragma unroll
            for (int m = 0; m < 4; ++m) {
                bf16_t* p = H + (size_t)(row0 + ai * HALF + m * 16) * ldh + col0;
                const f32x4 g0 = acc[ai][0][m][0], g1 = acc[ai][0][m][1], u0 = acc[ai][1][m][0], u1 = acc[ai][1][m][1];
                float h[8];
#pragma unroll
                for (int j = 0; j < 4; ++j) { h[j] = g0[j] * fsigmoid(g0[j]) * u0[j]; h[4 + j] = g1[j] * fsigmoid(g1[j]) * u1[j]; }
                u32x4 w; w.x = cvt_pk_bf16(h[0], h[1]); w.y = cvt_pk_bf16(h[2], h[3]); w.z = cvt_pk_bf16(h[4], h[5]); w.w = cvt_pk_bf16(h[6], h[7]);
                *(u32x4*)p = w;
            }
    }
};
struct EpiRes {
    static constexpr bool PERM = false, AFTER_DRAIN = false;
    const float* base; float* out; const bf16_t* add; float alpha, s;
    __device__ __forceinline__ void operator()(const f32x4 (&acc)[2][2][4][2], const Unit& u, int wr, int wc, int fr, int fq) const {
        EPI_IDS();
        const int row0 = u.pm * BM + wr * 64 + fr, col0 = u.pn * BM + wc * 32 + 4 * fq;
#pragma unroll
        for (int ai = 0; ai < 2; ++ai)
#pragma unroll
            for (int m = 0; m < 4; ++m) {
                const size_t off = (size_t)(row0 + ai * HALF + m * 16) * 1024 + col0;
#pragma unroll
                for (int bj = 0; bj < 2; ++bj)
#pragma unroll
                    for (int n = 0; n < 2; ++n) {
                        const size_t o = off + bj * HALF + n * 16;
                        const f32x4 b = *(const f32x4*)(base + o);
                        f32x4 v = b * alpha + acc[ai][bj][m][n] * s;
                        if (add) { const u32x2 a = *(const u32x2*)(add + o); v[0] += bf_lo(a.x); v[1] += bf_hi(a.x); v[2] += bf_lo(a.y); v[3] += bf_hi(a.y); }
                        *(f32x4*)(out + o) = v;
                    }
            }
    }
};
struct EpiSplit {
    static constexpr bool PERM = true, AFTER_DRAIN = false;
    unsigned char* ar; int mode; const float* tbias;
    __device__ __forceinline__ void operator()(const f32x4 (&acc)[2][2][4][2], const Unit& u, int wr, int wc, int fr, int fq) const {
        EPI_IDS();
        const int pn = u.pn; const int row0 = u.pm * BM + wr * 64 + fr;
        const int tail_tile = (mode == 0) ? 12 : (mode == 2 ? 8 : -1);
        if (pn == tail_tile) {
            float* tail = (float*)(ar + ((mode == 0) ? (size_t)192 << 20 : (size_t)474 << 20));
            if (wc == 0 && fq < 2) {
#pragma unroll
                for (int ai = 0; ai < 2; ++ai)
#pragma unroll
                    for (int m = 0; m < 4; ++m)
#pragma unroll
                        for (int n = 0; n < 2; ++n) {
                            f32x4 v = acc[ai][0][m][n]; const int c = 8 * fq + 4 * n;
                            if (mode == 2) {
#pragma unroll
                                for (int j = 0; j < 4; ++j) v[j] = flogsig(v[j] + tbias[c + j]);
                            }
                            *(f32x4*)(tail + (size_t)(row0 + ai * HALF + m * 16) * 16 + c) = v;
                        }
            }
            return;
        }
        size_t boff; int ld, tb; float sc = 1.f;
        if (mode == 0) { if (pn < 2) { boff = 0; ld = 512; tb = 0; sc = 0.08838834764831845f; } else if (pn < 4) { boff = (size_t)32 << 20; ld = 512; tb = 2; } else if (pn < 8) { boff = (size_t)64 << 20; ld = 1024; tb = 4; } else { boff = (size_t)128 << 20; ld = 1024; tb = 8; } }
        else if (mode == 1) { boff = (size_t)280 << 20; ld = 1024; tb = 0; }
        else if (mode == 2) { if (pn < 4) { boff = (size_t)344 << 20; tb = 0; } else { boff = (size_t)408 << 20; tb = 4; } ld = 1024; }
        else { if (pn < 4) { boff = 0; tb = 0; sc = 0.125f * 1.4426950408889634f; } else { boff = (size_t)64 << 20; tb = 4; } ld = 1024; }
        bf16_t* base = (bf16_t*)(ar + boff);
        const int col0 = (pn - tb) * BM + wc * 32 + 8 * fq;
#pragma unroll
        for (int ai = 0; ai < 2; ++ai)
#pragma unroll
            for (int m = 0; m < 4; ++m) {
                bf16_t* rowp = base + (size_t)(row0 + ai * HALF + m * 16) * ld + col0;
#pragma unroll
                for (int bj = 0; bj < 2; ++bj) {
                    const f32x4 v0 = acc[ai][bj][m][0] * sc, v1 = acc[ai][bj][m][1] * sc;
                    u32x4 w; w.x = cvt_pk_bf16(v0[0], v0[1]); w.y = cvt_pk_bf16(v0[2], v0[3]); w.z = cvt_pk_bf16(v1[0], v1[1]); w.w = cvt_pk_bf16(v1[2], v1[3]);
                    *(u32x4*)(rowp + bj * HALF) = w;
                }
            }
    }
};
struct EpiPle {
    static constexpr bool PERM = true, AFTER_DRAIN = false;
    bf16_t* P;
    __device__ __forceinline__ void operator()(const f32x4 (&acc)[2][2][4][2], const Unit& u, int wr, int wc, int fr, int fq) const {
        EPI_IDS();
        const int row0 = u.pm * BM + wr * 64 + fr, col0 = u.pn * BM + wc * 32 + 8 * fq;
#pragma unroll
        for (int ai = 0; ai < 2; ++ai)
#pragma unroll
            for (int m = 0; m < 4; ++m) {
                bf16_t* rowp = P + (size_t)(row0 + ai * HALF + m * 16) * 1024 + col0;
#pragma unroll
                for (int bj = 0; bj < 2; ++bj) {
                    const u32x4 pv = *(const u32x4*)(rowp + bj * HALF);
                    const f32x4 v0 = acc[ai][bj][m][0], v1 = acc[ai][bj][m][1];
                    u32x4 w;
                    w.x = cvt_pk_bf16(fsigmoid(v0[0]) * bf_lo(pv.x), fsigmoid(v0[1]) * bf_hi(pv.x));
                    w.y = cvt_pk_bf16(fsigmoid(v0[2]) * bf_lo(pv.y), fsigmoid(v0[3]) * bf_hi(pv.y));
                    w.z = cvt_pk_bf16(fsigmoid(v1[0]) * bf_lo(pv.z), fsigmoid(v1[1]) * bf_hi(pv.z));
                    w.w = cvt_pk_bf16(fsigmoid(v1[2]) * bf_lo(pv.w), fsigmoid(v1[3]) * bf_hi(pv.w));
                    *(u32x4*)(rowp + bj * HALF) = w;
                }
            }
    }
};

template <class Epi, class Sched, bool ALIGN_EPI = false, bool SP2 = false>
__device__ __forceinline__ void gemm_phase(PG8_LAS unsigned char* lds, const Gemm g, const Sched& S, const Epi& E) {
    int tid = threadIdx.x; asm volatile("" : "+v"(tid)); const int wid = __builtin_amdgcn_readfirstlane(tid >> 6), lane = tid & 63, wr = wid >> 2, wc = wid & 3, fr = lane & 15, fq = lane >> 4;
    const int K = g.K, nt = K / BK;
    unsigned voffA[2], voffB[2];
#pragma unroll
    for (int i = 0; i < 2; ++i) { int R, C; stage_rc(tid * 16 + i * 8192, R, C); const int Rb = Epi::PERM ? ((R & ~31) + perm32(R & 31)) : R;
        voffA[i] = (unsigned)(R * K + C) * 2u; voffB[i] = (unsigned)(Rb * K + C) * 2u; }
    const size_t kstep = (size_t)(BK * 2);
    const size_t hstep = (size_t)HALF * K * 2;
    const size_t tstep = 2 * hstep;
    const unsigned ldsw = (unsigned)wid * 1024u;
    const int aoff = lds_byte(wr * 64 + fr, fq * 8), boff = lds_byte(wc * 32 + fr, fq * 8);
#define PG8_SA(b, h) (((b) * 2 + (h)) * HTB)
#define PG8_SB(b, h) ((4 + (b) * 2 + (h)) * HTB)
#define PG8_STAGE(bufoff, gbase, voff) do { _Pragma("unroll") for (int _i = 0; _i < 2; ++_i) \
        __builtin_amdgcn_global_load_lds((const unsigned*)((const char*)(gbase) + (voff)[_i]), (PG8_LAS unsigned*)(lds + (bufoff) + ldsw + _i * 8192), 16, 0, 0); } while (0)
#define PG8_LDA(dst, b, h) do { _Pragma("unroll") for (int m = 0; m < 4; ++m) _Pragma("unroll") for (int k = 0; k < 2; ++k) dst[m][k] = *(const PG8_LAS bf16x8*)(lds + PG8_SA(b, h) + aoff + m * 2048 + k * 1024); } while (0)
#define PG8_LDB(dst, b, h) do { _Pragma("unroll") for (int n = 0; n < 2; ++n) _Pragma("unroll") for (int k = 0; k < 2; ++k) dst[n][k] = *(const PG8_LAS bf16x8*)(lds + PG8_SB(b, h) + boff + n * 2048 + k * 1024); } while (0)
#define PG8_MMA(ai, bj, At, Bt) do { __builtin_amdgcn_s_setprio(1); _Pragma("unroll") for (int m = 0; m < 4; ++m) _Pragma("unroll") for (int n = 0; n < 2; ++n) _Pragma("unroll") for (int k = 0; k < 2; ++k) \
        acc[ai][bj][m][n] = __builtin_amdgcn_mfma_f32_16x16x32_bf16(Bt[n][k], At[m][k], acc[ai][bj][m][n], 0, 0, 0); __builtin_amdgcn_s_setprio(0); } while (0)
#define PG8_WAIT_V(n) asm volatile("s_waitcnt vmcnt(" #n ")" ::: "memory")
#define PG8_WAIT_L(n) asm volatile("s_waitcnt lgkmcnt(" #n ")" ::: "memory")
#define PG8_BAR __builtin_amdgcn_s_barrier()
#define PG8_SCHED __builtin_amdgcn_sched_barrier(0)
    Unit cur, nxt; int ui = 0;
    if (!S.next(0, cur)) return;
    f32x4 acc[2][2][4][2];
#pragma unroll
    for (int a = 0; a < 2; ++a)
#pragma unroll
        for (int b = 0; b < 2; ++b)
#pragma unroll
            for (int m = 0; m < 4; ++m)
#pragma unroll
                for (int n = 0; n < 2; ++n) acc[a][b][m][n] = (f32x4){0.f, 0.f, 0.f, 0.f};
    bf16x8 At[4][2], B0[2][2], B1[2][2];
    const char* cA = (const char*)g.A + (size_t)cur.pm * tstep; const char* cB = (const char*)g.Bt + (size_t)cur.pn * tstep;
    S.a_ready(cur);
    if constexpr (SP2) {
        PG8_STAGE(PG8_SB(0, 0), cB, voffB); PG8_STAGE(PG8_SB(0, 1), cB + hstep, voffB); PG8_STAGE(PG8_SA(0, 0), cA, voffA); PG8_STAGE(PG8_SA(0, 1), cA + hstep, voffA);
        if (wr == 1) PG8_BAR;
        PG8_WAIT_V(2); PG8_BAR;
        PG8_STAGE(PG8_SB(1, 0), cB + kstep, voffB); PG8_STAGE(PG8_SA(1, 0), cA + kstep, voffA); PG8_STAGE(PG8_SB(1, 1), cB + hstep + kstep, voffB);
        PG8_WAIT_V(6); PG8_BAR;
    } else {
        PG8_STAGE(PG8_SB(0, 0), cB, voffB); PG8_STAGE(PG8_SA(0, 0), cA, voffA); PG8_STAGE(PG8_SB(0, 1), cB + hstep, voffB); PG8_STAGE(PG8_SA(0, 1), cA + hstep, voffA);
        if (wr == 1) PG8_BAR;
        PG8_WAIT_V(4); PG8_BAR;
        PG8_STAGE(PG8_SB(1, 0), cB + kstep, voffB); PG8_STAGE(PG8_SA(1, 0), cA + kstep, voffA); PG8_STAGE(PG8_SB(1, 1), cB + hstep + kstep, voffB);
        PG8_WAIT_V(6); PG8_BAR;
    }
    for (;;) {
        const bool has_next = S.next(ui + 1, nxt);
        const char* nA = has_next ? (const char*)g.A + (size_t)nxt.pm * tstep : cA; const char* nB = has_next ? (const char*)g.Bt + (size_t)nxt.pn * tstep : cB;
        for (int t = 0; t < nt; t += 2) {
            const bool last = (t == nt - 2);
            const char* a1 = cA + (size_t)(t + 1) * kstep;
            const char* a2 = last ? nA : cA + (size_t)(t + 2) * kstep; const char* b2 = last ? nB : cB + (size_t)(t + 2) * kstep;
            const char* a3 = a2 + kstep; const char* b3 = b2 + kstep;
            if (last && has_next) S.a_ready(nxt);
            if constexpr (SP2) {
            PG8_LDB(B0, 0, 0); PG8_LDB(B1, 0, 1); PG8_SCHED; PG8_LDA(At, 0, 0); PG8_STAGE(PG8_SA(1, 1), a1 + hstep, voffA);
            PG8_WAIT_V(8); PG8_WAIT_L(0); PG8_BAR; PG8_MMA(0, 0, At, B0); PG8_MMA(0, 1, At, B1); PG8_BAR; PG8_SCHED;
            PG8_LDA(At, 0, 1); PG8_STAGE(PG8_SB(0, 0), b2, voffB); PG8_STAGE(PG8_SB(0, 1), b2 + hstep, voffB); PG8_STAGE(PG8_SA(0, 0), a2, voffA);
            PG8_WAIT_V(8); PG8_WAIT_L(0); PG8_BAR; PG8_MMA(1, 0, At, B0); PG8_MMA(1, 1, At, B1); PG8_BAR; PG8_SCHED;
            PG8_LDB(B0, 1, 0); PG8_LDB(B1, 1, 1); PG8_SCHED; PG8_LDA(At, 1, 0); PG8_STAGE(PG8_SA(0, 1), a2 + hstep, voffA);
            PG8_WAIT_V(8); PG8_WAIT_L(0); PG8_BAR; PG8_MMA(0, 0, At, B0); PG8_MMA(0, 1, At, B1); PG8_BAR; PG8_SCHED;
            PG8_LDA(At, 1, 1); PG8_STAGE(PG8_SB(1, 0), b3, voffB); PG8_STAGE(PG8_SB(1, 1), b3 + hstep, voffB); PG8_STAGE(PG8_SA(1, 0), a3, voffA);
            PG8_WAIT_V(8); PG8_WAIT_L(0); PG8_BAR; PG8_MMA(1, 0, At, B0); PG8_MMA(1, 1, At, B1); PG8_BAR; PG8_SCHED;
            } else {
            PG8_LDB(B0, 0, 0); PG8_SCHED; PG8_LDA(At, 0, 0); PG8_STAGE(PG8_SA(1, 1), a1 + hstep, voffA);
            PG8_WAIT_L(8); PG8_BAR; PG8_WAIT_L(0); PG8_MMA(0, 0, At, B0); PG8_BAR; PG8_SCHED;
            PG8_LDB(B1, 0, 1); PG8_STAGE(PG8_SB(0, 0), b2, voffB);
            PG8_BAR; PG8_WAIT_L(0); PG8_MMA(0, 1, At, B1); PG8_BAR;
            PG8_LDA(At, 0, 1); PG8_STAGE(PG8_SA(0, 0), a2, voffA);
            PG8_BAR; PG8_WAIT_L(0); PG8_MMA(1, 0, At, B0); PG8_BAR; PG8_SCHED;
            PG8_STAGE(PG8_SB(0, 1), b2 + hstep, voffB);
            PG8_WAIT_V(6); PG8_BAR; PG8_MMA(1, 1, At, B1); PG8_BAR;
            PG8_LDB(B0, 1, 0); PG8_SCHED; PG8_LDA(At, 1, 0); PG8_STAGE(PG8_SA(0, 1), a2 + hstep, voffA);
            PG8_WAIT_L(8); PG8_BAR; PG8_WAIT_L(0); PG8_MMA(0, 0, At, B0); PG8_BAR; PG8_SCHED;
            PG8_LDB(B1, 1, 1); PG8_STAGE(PG8_SB(1, 0), b3, voffB);
            PG8_BAR; PG8_WAIT_L(0); PG8_MMA(0, 1, At, B1); PG8_BAR;
            PG8_LDA(At, 1, 1); PG8_STAGE(PG8_SA(1, 0), a3, voffA);
            PG8_BAR; PG8_WAIT_L(0); PG8_MMA(1, 0, At, B0); PG8_BAR; PG8_SCHED;
            PG8_STAGE(PG8_SB(1, 1), b3 + hstep, voffB);
            PG8_WAIT_V(6); PG8_BAR; PG8_MMA(1, 1, At, B1); PG8_BAR;
            }
        }
        if constexpr (ALIGN_EPI) { if (wr == 0) PG8_BAR; }
        if constexpr (!Epi::AFTER_DRAIN) { E(acc, cur, wr, wc, fr, fq); S.done(cur); }
        if (!has_next) break;
#pragma unroll
        for (int a = 0; a < 2; ++a)
#pragma unroll
            for (int b = 0; b < 2; ++b)
#pragma unroll
                for (int m = 0; m < 4; ++m)
#pragma unroll
                    for (int n = 0; n < 2; ++n) acc[a][b][m][n] = (f32x4){0.f, 0.f, 0.f, 0.f};
        cur = nxt; cA = nA; cB = nB; ++ui;
        if constexpr (ALIGN_EPI) { if (wr == 1) PG8_BAR; }
    }
    PG8_WAIT_V(0);
    if constexpr (!ALIGN_EPI) { if (wr == 0) PG8_BAR; }
    PG8_BAR;
    if constexpr (Epi::AFTER_DRAIN) { E.fused(acc, cur, wr, wc, fr, fq, lds, wid, lane); S.done(cur); }
#undef PG8_SA
#undef PG8_SB
#undef PG8_STAGE
#undef PG8_LDA
#undef PG8_LDB
#undef PG8_MMA
#undef PG8_WAIT_V
#undef PG8_WAIT_L
#undef PG8_BAR
#undef PG8_SCHED
}
}
#include <hip/hip_bf16.h>
#include <cmath>
namespace attn_body {
using bf16=__hip_bfloat16;
using bf16x8=__attribute__((ext_vector_type(8)))short;
using s16x4=__attribute__((ext_vector_type(4)))short;
using f32x16=__attribute__((ext_vector_type(16)))float;
using u32x4=__attribute__((ext_vector_type(4)))unsigned;
constexpr int BATCH=2,NHEAD=16,SEQ=16384,D=64,DM=NHEAD*D;
constexpr int NW=8,QBLK=32,QB=QBLK*NW,KVBLK=64,NQB=SEQ/QB;
constexpr int ATTN_PITCH=DM, ATTN_UNIT_ROWS=QB;
__device__ __forceinline__ int crow(int r,int hi){return (r&3)+8*(r>>2)+4*hi;}
#define SBAR() __builtin_amdgcn_sched_barrier(0)
__device__ __forceinline__ void cmask(f32x16&p0,f32x16&p1,int jb,int qrel,int hi){
  const float NEG=-INFINITY; int kb=64*jb+4*hi;
  #pragma unroll
  for(int r=0;r<16;++r){int kv=kb+(r&3)+8*(r>>2); if(kv>qrel)p0[r]=NEG; if(kv+32>qrel)p1[r]=NEG;}
}

constexpr int NSLOT=3, SLOTB=8192;
constexpr int LDS_K=0, LDS_V=NSLOT*SLOTB, LDS_WS=2*NSLOT*SLOTB, LDS_OST=LDS_WS+NW*64*4, LDS_BETA=LDS_OST+NW*4096, LDS_MISC=LDS_BETA+SEQ*4, LDS_BYTES=LDS_MISC+64;
constexpr float C2=0.125f*1.4426950408889634f;
__device__ __forceinline__ void glds16(const void*gsrc,unsigned lds_dst){unsigned keep;
  asm volatile("s_mov_b32 %0, m0\n\ts_mov_b32 m0, %2\n\ts_nop 0\n\tglobal_load_lds_dwordx4 %1, off\n\ts_mov_b32 m0, %0":"=&s"(keep):"v"(gsrc),"s"(lds_dst):"memory");}
__device__ __forceinline__ float max3f(float a,float b,float c){float r;asm("v_max3_f32 %0, %1, %2, %3":"=v"(r):"v"(a),"v"(b),"v"(c));return r;}
__device__ __forceinline__ float max2f(float a,float b){float r;asm("v_max_f32_e32 %0, %1, %2":"=v"(r):"v"(a),"v"(b));return r;}
__device__ __forceinline__ float fadd_s(float a,float b){float r;asm("v_add_f32_e32 %0, %1, %2":"=v"(r):"v"(a),"v"(b));return r;}
__device__ __forceinline__ float fsub_s(float a,float b){float r;asm("v_sub_f32_e32 %0, %1, %2":"=v"(r):"v"(a),"v"(b));return r;}
typedef float f32x4_t __attribute__((ext_vector_type(4))); typedef float f32x2_t __attribute__((ext_vector_type(2))); typedef __bf16 bf16x2_t __attribute__((ext_vector_type(2)));
__device__ __forceinline__ unsigned cvtpk_s(float lo,float hi){f32x2_t v={lo,hi};bf16x2_t b=__builtin_convertvector(v,bf16x2_t);return __builtin_bit_cast(unsigned,b);}
#define WAIT_BAR(N) asm volatile("s_waitcnt vmcnt(" #N ") lgkmcnt(0)\n\ts_barrier":::"memory")

__device__ __forceinline__ void qkt(f32x16&p0,f32x16&p1,const char*Kslot,const bf16x8*qr,const f32x16&negm,int r32,int hi){
  const char*kb=Kslot+hi*1024+r32*16;
  #pragma unroll
  for(int d0=0;d0<4;++d0){
    const bf16x8 b0=*reinterpret_cast<const bf16x8*>(kb+d0*2048);
    const bf16x8 b1=*reinterpret_cast<const bf16x8*>(kb+d0*2048+512);
    if(d0==0){p0=__builtin_amdgcn_mfma_f32_32x32x16_bf16(b0,qr[0],negm,0,0,0);p1=__builtin_amdgcn_mfma_f32_32x32x16_bf16(b1,qr[0],negm,0,0,0);}
    else{p0=__builtin_amdgcn_mfma_f32_32x32x16_bf16(b0,qr[d0],p0,0,0,0);p1=__builtin_amdgcn_mfma_f32_32x32x16_bf16(b1,qr[d0],p1,0,0,0);}}
}
typedef __attribute__((address_space(3))) const char* lds_cptr;
typedef short v4i16_t __attribute__((ext_vector_type(4)));
__device__ __forceinline__ void kload8(bf16x8*kf,lds_cptr kp){
  kf[0]=*(const __attribute__((address_space(3))) bf16x8*)(kp);      kf[1]=*(const __attribute__((address_space(3))) bf16x8*)(kp+512);
  kf[2]=*(const __attribute__((address_space(3))) bf16x8*)(kp+2048); kf[3]=*(const __attribute__((address_space(3))) bf16x8*)(kp+2560);
  kf[4]=*(const __attribute__((address_space(3))) bf16x8*)(kp+4096); kf[5]=*(const __attribute__((address_space(3))) bf16x8*)(kp+4608);
  kf[6]=*(const __attribute__((address_space(3))) bf16x8*)(kp+6144); kf[7]=*(const __attribute__((address_space(3))) bf16x8*)(kp+6656);
}
__device__ __forceinline__ void kload2(bf16x8*kf,lds_cptr kp,int j){ kf[2*j]=*(const __attribute__((address_space(3))) bf16x8*)(kp+j*2048); kf[2*j+1]=*(const __attribute__((address_space(3))) bf16x8*)(kp+j*2048+512); }
__device__ __forceinline__ s16x4 vtr(lds_cptr p){ return __builtin_bit_cast(s16x4,__builtin_amdgcn_ds_read_tr16_b64_v4i16((__attribute__((address_space(3))) v4i16_t*)p)); }
__device__ __forceinline__ float rowmax(const f32x16&p0,const f32x16&p1){
  float a=max3f(p0[0],p0[1],p1[0]),b=max3f(p0[2],p0[3],p1[1]);a=max3f(a,p1[2],p1[3]);
  #pragma unroll
  for(int r=4;r<16;r+=4){a=max3f(a,p0[r],p0[r+1]);b=max3f(b,p0[r+2],p0[r+3]);a=max3f(a,p1[r],p1[r+1]);b=max3f(b,p1[r+2],p1[r+3]);}
  const float m=max2f(a,b);
  auto rr=__builtin_amdgcn_permlane32_swap(__float_as_uint(m),__float_as_uint(m),false,false);
  return max2f(__uint_as_float(rr[0]),__uint_as_float(rr[1]));
}
__device__ __forceinline__ void pv(f32x16*o,int vb,bf16x8 pa0,bf16x8 pa1,bf16x8 pa2,bf16x8 pa3){
  #pragma unroll
  for(int d0=0;d0<2;++d0){s16x4 lo[4],hi[4];
    #pragma unroll
    for(int ks=0;ks<4;++ks){
      asm volatile("ds_read_b64_tr_b16 %0,%1 offset:%c2":"=&v"(lo[ks]):"v"(vb),"i"(d0*4096+ks*1024):"memory");
      asm volatile("ds_read_b64_tr_b16 %0,%1 offset:%c2":"=&v"(hi[ks]):"v"(vb),"i"(d0*4096+ks*1024+512):"memory");}
    asm volatile("s_waitcnt lgkmcnt(0)":::"memory");SBAR();
    #define PK(k) (bf16x8){lo[k][0],lo[k][1],lo[k][2],lo[k][3],hi[k][0],hi[k][1],hi[k][2],hi[k][3]}
    o[d0]=__builtin_amdgcn_mfma_f32_32x32x16_bf16(pa0,PK(0),o[d0],0,0,0);
    o[d0]=__builtin_amdgcn_mfma_f32_32x32x16_bf16(pa1,PK(1),o[d0],0,0,0);
    o[d0]=__builtin_amdgcn_mfma_f32_32x32x16_bf16(pa2,PK(2),o[d0],0,0,0);
    o[d0]=__builtin_amdgcn_mfma_f32_32x32x16_bf16(pa3,PK(3),o[d0],0,0,0);
    #undef PK
  }
}

#ifndef ATTN_STORE16
#define ATTN_STORE16(p,v) (*(u32x4*)(p)=(v))
#endif
template<int THRL> __device__ __forceinline__ void attn_unit(int b,int h,int qb,const bf16*Q,const bf16*__restrict__ K,const bf16*__restrict__ V,bf16*O,const bf16*__restrict__ Gt,const float*__restrict__ cs0,float kmax,char*shm){
  int tid=threadIdx.x; asm volatile("":"+v"(tid)); const int lane=tid&63,r32=lane&31,hi=lane>>5; const int wid=__builtin_amdgcn_readfirstlane(tid>>6);
  const long rowbase=(long)b*SEQ; const int q0=qb*QB;
  const bf16*Qw=Q+(rowbase+q0+wid*QBLK)*DM+h*D;
  bf16x8 qr[4];
  #pragma unroll
  for(int d0=0;d0<4;++d0)qr[d0]=*reinterpret_cast<const bf16x8*>(&Qw[(long)r32*DM+d0*16+hi*8]);
  int t0;
  { typedef __attribute__((address_space(3))) float* lds_fptr; typedef __attribute__((address_space(3))) int* lds_iptr;
    lds_fptr misc=(lds_fptr)((lds_cptr)shm+LDS_MISC);
    float nq=0.f;
    #pragma unroll
    for(int d0=0;d0<4;++d0){
      #pragma unroll
      for(int j=0;j<8;++j){const float f=__uint_as_float(((unsigned)(unsigned short)qr[d0][j])<<16); nq+=f*f;}}
    {auto rr=__builtin_amdgcn_permlane32_swap(__float_as_uint(nq),__float_as_uint(nq),false,false);nq=__uint_as_float(rr[0])+__uint_as_float(rr[1]);}
    nq=fmaxf(nq,__int_as_float(__builtin_amdgcn_ds_swizzle(__float_as_int(nq),(16<<10)|0x1f))); nq=fmaxf(nq,__int_as_float(__builtin_amdgcn_ds_swizzle(__float_as_int(nq),(8<<10)|0x1f)));
    nq=fmaxf(nq,__int_as_float(__builtin_amdgcn_ds_swizzle(__float_as_int(nq),(4<<10)|0x1f))); nq=fmaxf(nq,__int_as_float(__builtin_amdgcn_ds_swizzle(__float_as_int(nq),(2<<10)|0x1f)));
    nq=fmaxf(nq,__int_as_float(__builtin_amdgcn_ds_swizzle(__float_as_int(nq),(1<<10)|0x1f)));
    if(lane==0)misc[wid]=nq;
    if(tid==0)((lds_iptr)misc)[8]=0;
    asm volatile("s_waitcnt vmcnt(0) lgkmcnt(0)\n\ts_barrier":::"memory");
    float q2=misc[0];
    #pragma unroll
    for(int w_=1;w_<NW;++w_)q2=fmaxf(q2,misc[w_]);
    const float thr=-45.f-2.f*sqrtf(q2)*kmax*1.0001f;
    const int NT0=(q0+QB)/KVBLK; const float cref0=cs0[q0];
    if(tid>=1&&2*tid<=NT0-4){ const float bb=(cref0-cs0[128*tid-1])*1.4426950408889634f; if(bb<=thr)atomicMax((int*)((lds_iptr)misc+8),2*tid); }
    asm volatile("s_waitcnt vmcnt(0) lgkmcnt(0)\n\ts_barrier":::"memory");
    t0=__builtin_amdgcn_readfirstlane(((lds_iptr)misc)[8]);
  }
  const float*cs=cs0+t0*KVBLK;
  const bf16*Kh=K+(rowbase+(long)t0*KVBLK)*DM+h*D,*Vh=V+(rowbase+(long)t0*KVBLK)*DM+h*D;
  const unsigned lds0=(unsigned)(uintptr_t)shm;
  float*wsf=(float*)(shm+LDS_WS)+wid*64;
  const bf16*ksrc=Kh+(long)lane*DM+wid*8;
  const bf16*vsrc=Vh+(long)(16*(wid&3)+(lane>>2))*DM+(wid>>2)*32+(lane&3)*8;
  const unsigned kdst=lds0+LDS_K+wid*1024, vdst=lds0+LDS_V+wid*1024;
  #define DMA_K(t,slot) glds16(ksrc+(long)(t)*KVBLK*DM,(unsigned)__builtin_amdgcn_readfirstlane(kdst+(slot)))
  #define DMA_V(t,slot) glds16(vsrc+(long)(t)*KVBLK*DM,(unsigned)__builtin_amdgcn_readfirstlane(vdst+(slot)))
  const int vb0=(int)(lds0+LDS_V)+((lane>>4)&1)*32+(lane&3)*8+(4*hi+((lane&15)>>2))*64;
  const char*Kbase=shm+LDS_K; bf16x8 kf[8];
  const lds_cptr shm3=(lds_cptr)shm; const lds_cptr kp0=shm3+LDS_K+hi*1024+r32*16; const lds_cptr vp0=shm3+LDS_V+((lane>>4)&1)*32+(lane&3)*8+(4*hi+((lane&15)>>2))*64;
  const int NT=(q0+QB)/KVBLK-t0;
  {
    typedef __attribute__((address_space(3))) float* lds_fptr; lds_fptr bt=(lds_fptr)((lds_cptr)shm+LDS_BETA);
    const float cref=cs0[q0]; const int nkv=NT*KVBLK;
    for(int s_=tid;s_<nkv;s_+=NW*64) bt[s_]=(cref-cs[s_])*1.4426950408889634f;
  }
  const lds_cptr bp0=(lds_cptr)shm+LDS_BETA+hi*16;
  #define LDB(P0,P1,t) do{ const lds_cptr bq_=bp0+(t)*256; _Pragma("unroll") for(int g_=0;g_<4;++g_){ \
      const f32x4_t u0_=*(const __attribute__((address_space(3))) f32x4_t*)(bq_+g_*32), u1_=*(const __attribute__((address_space(3))) f32x4_t*)(bq_+128+g_*32); \
      P0[4*g_]=u0_[0];P0[4*g_+1]=u0_[1];P0[4*g_+2]=u0_[2];P0[4*g_+3]=u0_[3]; P1[4*g_]=u1_[0];P1[4*g_+1]=u1_[1];P1[4*g_+2]=u1_[2];P1[4*g_+3]=u1_[3]; } }while(0)
  DMA_K(0,0);DMA_V(0,0);DMA_K(1,SLOTB);
  float mhat=0.f,l_reg=0.f;f32x16 o[2];o[0]=f32x16{};o[1]=f32x16{};f32x16 zero16=f32x16{};
  const int qrel=wid*QBLK+r32;
  #define CMASK(P0,P1,t) do{int jb_=(t)-(NT-4); if(jb_>=0)cmask(P0,P1,jb_,qrel,hi);}while(0)
  bool resc=false;
  #define START(P0,P1) do{ const float rm=rowmax(P0,P1); resc=false; \
    { const float dl=rm; mhat=fadd_s(mhat,dl); \
      _Pragma("unroll") for(int r=0;r<16;++r){P0[r]=fsub_s(P0[r],dl);P1[r]=fsub_s(P1[r],dl);} } \
    _Pragma("unroll") for(int r=0;r<16;++r)P0[r]=__builtin_amdgcn_exp2f(P0[r]); }while(0)
  #define RESC() do{ if(resc){ asm volatile("s_waitcnt lgkmcnt(0)":::"memory"); \
      _Pragma("unroll") for(int d_=0;d_<2;++d_) _Pragma("unroll") for(int r=0;r<16;++r)o[d_][r]*=wsf[crow(r,hi)]; } }while(0)
  f32x16 pA0,pA1,pB0,pB1;
  int sl_prev=0,sl_cur=0,sl_next=SLOTB;
  #define ROT() do{sl_prev=sl_cur;sl_cur=sl_next;sl_next=(sl_next==(NSLOT-1)*SLOTB)?0:sl_next+SLOTB;}while(0)
  DMA_K(2,2*SLOTB);
  WAIT_BAR(3);
  qkt(pA0,pA1,Kbase,qr,zero16,r32,hi);asm volatile("s_nop 15\n\ts_nop 7":"+v"(pA0),"+v"(pA1));
  { LDB(pB0,pB1,0); _Pragma("unroll") for(int r=0;r<16;++r){pA0[r]+=pB0[r];pA1[r]+=pB1[r];} }
  CMASK(pA0,pA1,0);
  START(pA0,pA1);
  _Pragma("unroll") for(int r=0;r<16;++r)pA1[r]=__builtin_amdgcn_exp2f(pA1[r]);
  LDB(pB0,pB1,1);
  WAIT_BAR(0);
  DMA_K(3,0);DMA_V(1,SLOTB);
  ROT();
  kload8(kf,kp0+sl_cur);
  WAIT_BAR(2);
  s16x4 vlo[8],vhi[8]; u32x4 pw0,pw1,pw2,pw3;
  #define PKW(P,B) cvtpk_s(P[B],P[B+1])
  #define PAF(k) __builtin_bit_cast(bf16x8,pw##k)
  #define VFR(i) (bf16x8){vlo[i][0],vlo[i][1],vlo[i][2],vlo[i][3],vhi[i][0],vhi[i][1],vhi[i][2],vhi[i][3]}
  #define PIN(x) asm volatile("":"+v"(x))
  #define MX3(a,b,c) __builtin_fmaxf(__builtin_fmaxf((a),(b)),(c))
  #define GAPA(MF,A0,A1,A2,A3,W0,W1,PW) do{ MF; sacc+=A0; sacc+=A1; sacc+=A2; sacc+=A3; PIN(sacc); W0; W1; PIN(PW); SBAR(); }while(0)
  #define EX(v) __builtin_amdgcn_exp2f(v)
  #define GAPB(MF,X,B) do{ MF; X[B]=EX(X[B]); X[B+1]=EX(X[B+1]); X[B+2]=EX(X[B+2]); X[B+3]=EX(X[B+3]); PIN(X); SBAR(); }while(0)
  #define VRD(i) do{ vlo[i]=vtr(vp_+(((i)>>2)*4096+((i)&3)*1024)); vhi[i]=vtr(vp_+(((i)>>2)*4096+((i)&3)*1024+512)); }while(0)
  #define KRD(G,j) do{ if(G){ kload2(kf,kp0+sl_next,j); SBAR(); } }while(0)
  #define STEP(C0,C1,P0,P1,t,GK,GV,GL) do{ SBAR(); \
    const lds_cptr vp_=vp0+sl_prev; \
    _Pragma("unroll") for(int r=0;r<16;++r){C0[r]-=mhat;C1[r]-=mhat;} \
    VRD(0); SBAR(); float sacc=(P0[0]+P0[1]); \
    GAPA(C0=__builtin_amdgcn_mfma_f32_32x32x16_bf16(kf[0],qr[0],C0,0,0,0), P0[2],P0[3],P0[4],P0[5],     pw0[0]=PKW(P0,0), pw0[1]=PKW(P0,2), pw0); \
    VRD(4); SBAR(); GAPA(C1=__builtin_amdgcn_mfma_f32_32x32x16_bf16(kf[1],qr[0],C1,0,0,0), P0[6],P0[7],P0[8],P0[9],     pw0[2]=PKW(P0,4), pw0[3]=PKW(P0,6), pw0); \
    VRD(1); SBAR(); GAPA(C0=__builtin_amdgcn_mfma_f32_32x32x16_bf16(kf[2],qr[1],C0,0,0,0),   P0[10],P0[11],P0[12],P0[13], pw1[0]=PKW(P0,8), pw1[1]=PKW(P0,10), pw1); \
    VRD(5); SBAR(); GAPA(C1=__builtin_amdgcn_mfma_f32_32x32x16_bf16(kf[3],qr[1],C1,0,0,0),   P0[14],P0[15],P1[0],P1[1],   pw1[2]=PKW(P0,12),pw1[3]=PKW(P0,14), pw1); \
    VRD(2); SBAR(); GAPA(C0=__builtin_amdgcn_mfma_f32_32x32x16_bf16(kf[4],qr[2],C0,0,0,0),   P1[2],P1[3],P1[4],P1[5],     pw2[0]=PKW(P1,0), pw2[1]=PKW(P1,2), pw2); \
    VRD(6); SBAR(); GAPA(C1=__builtin_amdgcn_mfma_f32_32x32x16_bf16(kf[5],qr[2],C1,0,0,0),   P1[6],P1[7],P1[8],P1[9],     pw2[2]=PKW(P1,4), pw2[3]=PKW(P1,6), pw2); \
    VRD(3); SBAR(); GAPA(C0=__builtin_amdgcn_mfma_f32_32x32x16_bf16(kf[6],qr[3],C0,0,0,0),   P1[10],P1[11],P1[12],P1[13], pw3[0]=PKW(P1,8), pw3[1]=PKW(P1,10), pw3); \
    VRD(7); SBAR(); GAPA(C1=__builtin_amdgcn_mfma_f32_32x32x16_bf16(kf[7],qr[3],C1,0,0,0),   P1[14],P1[15],0.f,0.f,       pw3[2]=PKW(P1,12),pw3[3]=PKW(P1,14), pw3); \
    l_reg+=sacc; \
    if(GV){LDB(P0,P1,(t)+1);} \
    if(GK){DMA_K((t)+3,sl_cur);} if(GV){DMA_V((t)+1,sl_next);} \
    CMASK(C0,C1,t); \
    { float a=MX3(C0[0],C0[1],C1[0]),b=MX3(C0[2],C0[3],C1[1]); a=MX3(a,C1[2],C1[3]); \
      _Pragma("unroll") for(int r=4;r<16;r+=4){a=MX3(a,C0[r],C0[r+1]);b=MX3(b,C0[r+2],C0[r+3]);a=MX3(a,C1[r],C1[r+1]);b=MX3(b,C1[r+2],C1[r+3]);} \
      float rm=__builtin_fmaxf(a,b); { auto rr=__builtin_amdgcn_permlane32_swap(__float_as_uint(rm),__float_as_uint(rm),false,false); rm=__builtin_fmaxf(__uint_as_float(rr[0]),__uint_as_float(rr[1])); } \
      resc=false; \
      if(__builtin_expect(__any(rm>(float)THRL),0)){ const float dl=__builtin_fmaxf(rm,0.f); mhat+=dl; \
        _Pragma("unroll") for(int r=0;r<16;++r){C0[r]-=dl;C1[r]-=dl;} \
        const float f=__builtin_amdgcn_exp2f(-dl); l_reg*=f; if(hi==0)wsf[r32]=f; resc=true; } } \
    SBAR(); \
    GAPB(o[0]=__builtin_amdgcn_mfma_f32_32x32x16_bf16(PAF(0),VFR(0),o[0],0,0,0), C0,0); \
    GAPB(o[1]=__builtin_amdgcn_mfma_f32_32x32x16_bf16(PAF(0),VFR(4),o[1],0,0,0), C0,4); \
    KRD(GL,0); GAPB(o[0]=__builtin_amdgcn_mfma_f32_32x32x16_bf16(PAF(1),VFR(1),o[0],0,0,0), C0,8); \
    KRD(GL,1); GAPB(o[1]=__builtin_amdgcn_mfma_f32_32x32x16_bf16(PAF(1),VFR(5),o[1],0,0,0), C0,12); \
    KRD(GL,2); GAPB(o[0]=__builtin_amdgcn_mfma_f32_32x32x16_bf16(PAF(2),VFR(2),o[0],0,0,0), C1,0); \
    KRD(GL,3); GAPB(o[1]=__builtin_amdgcn_mfma_f32_32x32x16_bf16(PAF(2),VFR(6),o[1],0,0,0), C1,4); \
    GAPB(o[0]=__builtin_amdgcn_mfma_f32_32x32x16_bf16(PAF(3),VFR(3),o[0],0,0,0), C1,8); \
    GAPB(o[1]=__builtin_amdgcn_mfma_f32_32x32x16_bf16(PAF(3),VFR(7),o[1],0,0,0), C1,12); \
    }while(0)
  int t=1;
  #undef CMASK
  #define CMASK(P0,P1,t) do{}while(0)
  for(;t+5<NT;t+=2){
    STEP(pB0,pB1,pA0,pA1,t,true,true,true);     WAIT_BAR(2); RESC(); ROT();
    STEP(pA0,pA1,pB0,pB1,t+1,true,true,true);   WAIT_BAR(2); RESC(); ROT();
  }
  #undef CMASK
  #define CMASK(P0,P1,t) do{int jb_=(t)-(NT-4); if(jb_>=0)cmask(P0,P1,jb_,qrel,hi);}while(0)
  #define ENDW(tt) do{ if((tt)+3<NT){WAIT_BAR(2);} else if((tt)+2<NT){WAIT_BAR(1);} else {WAIT_BAR(0);} }while(0)
  for(;t+1<NT;t+=2){
    STEP(pB0,pB1,pA0,pA1,t,(t+3<NT),(t+1<NT),(t+1<NT));       ENDW(t);   RESC(); ROT();
    STEP(pA0,pA1,pB0,pB1,t+1,(t+4<NT),(t+2<NT),(t+2<NT));     ENDW(t+1); RESC(); ROT();
  }
  STEP(pB0,pB1,pA0,pA1,NT-1,false,false,false); RESC();
  { float sacc=pB0[0]+pB0[1]; _Pragma("unroll") for(int r=2;r<16;++r)sacc+=pB0[r]; _Pragma("unroll") for(int r=0;r<16;++r)sacc+=pB1[r]; l_reg+=sacc;
    pw0=(u32x4){PKW(pB0,0),PKW(pB0,2),PKW(pB0,4),PKW(pB0,6)};pw1=(u32x4){PKW(pB0,8),PKW(pB0,10),PKW(pB0,12),PKW(pB0,14)};pw2=(u32x4){PKW(pB1,0),PKW(pB1,2),PKW(pB1,4),PKW(pB1,6)};pw3=(u32x4){PKW(pB1,8),PKW(pB1,10),PKW(pB1,12),PKW(pB1,14)};
    SBAR(); pv(o,vb0+sl_cur,PAF(0),PAF(1),PAF(2),PAF(3)); }
  #undef PKW
  #undef PAF
  #undef VFR
  #undef PIN
  #undef MX3
  #undef GAPA
  #undef GAPB
  #undef EX
  #undef VRD
  #undef KRD
  #undef STEP
  #undef ENDW
  {auto rr=__builtin_amdgcn_permlane32_swap(__float_as_uint(l_reg),__float_as_uint(l_reg),false,false);l_reg=__uint_as_float(rr[0])+__uint_as_float(rr[1]);}
  if(hi==0)wsf[32+r32]=l_reg;asm volatile("s_waitcnt lgkmcnt(0)":::"memory");
  float rli[16];
  #pragma unroll
  for(int r=0;r<16;++r)rli[r]=__builtin_amdgcn_rcpf(wsf[32+crow(r,hi)]);
  bf16*Ow=O+(rowbase+q0+wid*QBLK)*DM+h*D;
  { bf16*stg=(bf16*)(shm+LDS_OST)+wid*2048;
    #pragma unroll
    for(int r=0;r<16;++r){const int orow=crow(r,hi);
      #pragma unroll
      for(int d0=0;d0<2;++d0)stg[orow*64+d0*32+r32]=__float2bfloat16(o[d0][r]*rli[r]);}
    asm volatile("s_waitcnt lgkmcnt(0)":::"memory");
    const bf16*Gw=Gt+(rowbase+q0+wid*QBLK)*DM+h*D;
    #pragma unroll
    for(int i=0;i<4;++i){const int row=i*8+(lane>>3),ch=lane&7; u32x4 v=*(const u32x4*)(stg+row*64+ch*8); const u32x4 gq=*(const u32x4*)(Gw+(long)row*DM+ch*8);
      #pragma unroll
      for(int e=0;e<4;++e){ const float o0=__uint_as_float(v[e]<<16),o1=__uint_as_float(v[e]&0xffff0000u),g0=__uint_as_float(gq[e]<<16),g1=__uint_as_float(gq[e]&0xffff0000u);
        const float s0=__builtin_amdgcn_rcpf(1.f+__builtin_amdgcn_exp2f(-1.4426950408889634f*g0)),s1=__builtin_amdgcn_rcpf(1.f+__builtin_amdgcn_exp2f(-1.4426950408889634f*g1));
        v[e]=cvtpk_s(o0*s0,o1*s1); }
      ATTN_STORE16(Ow+(long)row*DM+ch*8,v);} }
  asm volatile("s_waitcnt lgkmcnt(0)\n\ts_barrier":::"memory");
  #undef DMA_K
  #undef DMA_V
  #undef LDB
  #undef CMASK
  #undef START
  #undef RESC
  #undef ROT
}
constexpr int ATTN_LDS_BYTES=LDS_BYTES;
struct AttnTensors { const bf16* Q; const bf16* K; const bf16* V; bf16* O; const bf16* G; const float* C; float kmax; };
struct AttnUnit { int bh; int qb; };
struct StaticOrder {
  int vcu,G;
  __device__ __forceinline__ explicit StaticOrder(int grid,int block):vcu((grid%8==0)?(block%8)*(grid/8)+block/8:block),G(grid){}
  __device__ __forceinline__ bool next(int i,AttnUnit&u)const{
    if(G==256){ if(i>=8)return false; const int s=vcu&7; u.bh=vcu>>3; const int qi=i*8+((i&1)?7-s:s); u.qb=NQB-1-qi; return true; }
    const int L=i*G+vcu; if(L>=BATCH*NHEAD*NQB)return false; u.bh=L%(BATCH*NHEAD); u.qb=NQB-1-L/(BATCH*NHEAD); return true; }
  __device__ __forceinline__ void a_ready(const AttnUnit&)const{}
  __device__ __forceinline__ void done(const AttnUnit&)const{}
};
template<class Sched,int THRL=8> __device__ __forceinline__ void attn_phase(char*lds,const AttnTensors&T,const Sched&S){
  AttnUnit u;
  for(int i=0;S.next(i,u);++i){ S.a_ready(u); attn_unit<THRL>(u.bh/NHEAD,u.bh%NHEAD,u.qb,T.Q,T.K,T.V,T.O,T.G,T.C+(long)u.bh*SEQ,T.kmax,lds); S.done(u); }
}
#undef SBAR
#undef WAIT_BAR
}
#ifndef PG8_SP2
#define PG8_SP2 true
#endif
#ifndef PG8_ALIGN
#define PG8_ALIGN true
#endif
constexpr int NWAVES = 8;
constexpr int SEQL = 16384, NB = 2, M = NB * SEQL, D = 1024, FF = 2816, PLE = 256, DEPTH = 4;
constexpr int GLA_IN = 3088, GLA_INP = 3328, KVF_N = 2064, KVF_NP = 2304;
constexpr int NCH = SEQL / 64;
constexpr float LN_EPS = 1e-5f;
constexpr float DN_ALPHA = 1.681792830507429f;
constexpr size_t MiB = 1u << 20;
constexpr size_t WS_W = 1 * MiB, WS_XB = 50 * MiB, WS_AR = 114 * MiB, WS_END = (114 + 476) * MiB;
constexpr size_t OW_F1IN = 0, OW_F1OUT = 5767168, OW_F2IN = 8650752, OW_F2OUT = 14417920, OW_PG = 17301504, OW_PP = 18350080, OW_MIXIN = 18612224, OW_MIXO = 22020096, OW_KVF = 23068672;
constexpr size_t AR_H = 0, AR_PB = 176 * MiB, AR_PLE = 280 * MiB, AR_KSH = 344 * MiB, AR_VSH = 408 * MiB, AR_CSH = 472 * MiB, AR_FLOG = 474 * MiB;
constexpr size_t AR_GQ = 0, AR_GK = 32 * MiB, AR_GV = 64 * MiB, AR_GR = 128 * MiB, AR_GA = 192 * MiB, AR_GD = 194 * MiB, AR_GKT = 196 * MiB, AR_GVT = 228 * MiB, AR_GST = 292 * MiB;
constexpr size_t AR_FQ = 0, AR_FG = 64 * MiB;
constexpr int LDS_BYTES = 150016;
static_assert(attn_body::ATTN_LDS_BYTES <= LDS_BYTES && pg8::STAGE_BYTES <= LDS_BYTES, "LDS map");

#define LAS __attribute__((address_space(3)))
typedef unsigned short bf16;
typedef unsigned v4u __attribute__((ext_vector_type(4)));
typedef unsigned v2u __attribute__((ext_vector_type(2)));
typedef float f32x4 __attribute__((ext_vector_type(4)));
typedef float f32x16 __attribute__((ext_vector_type(16)));
typedef short bf16x8 __attribute__((ext_vector_type(8)));
typedef short bf16x4 __attribute__((ext_vector_type(4)));
#define LDS_WAIT() asm volatile("s_waitcnt lgkmcnt(0)" ::: "memory")
__device__ __forceinline__ unsigned pk2(float lo, float hi) { typedef float f2 __attribute__((ext_vector_type(2))); typedef __bf16 b2 __attribute__((ext_vector_type(2))); f2 v = {lo, hi}; b2 b = __builtin_convertvector(v, b2); return __builtin_bit_cast(unsigned, b); }
__device__ __forceinline__ float bflo(unsigned w) { return __uint_as_float(w << 16); }
__device__ __forceinline__ float bfhi(unsigned w) { return __uint_as_float(w & 0xffff0000u); }
template <int O> __device__ __forceinline__ float swz_xor(float v) { return __int_as_float(__builtin_amdgcn_ds_swizzle(__float_as_int(v), (O << 10) | 0x1f)); }
__device__ __forceinline__ float half_sum(float v) { auto rr = __builtin_amdgcn_permlane32_swap(__float_as_uint(v), __float_as_uint(v), false, false); return __uint_as_float(rr[0]) + __uint_as_float(rr[1]); }
__device__ __forceinline__ float half_max(float v) { auto rr = __builtin_amdgcn_permlane32_swap(__float_as_uint(v), __float_as_uint(v), false, false); return fmaxf(__uint_as_float(rr[0]), __uint_as_float(rr[1])); }
__device__ __forceinline__ float wave_sum(float v) { v += swz_xor<1>(v); v += swz_xor<2>(v); v += swz_xor<4>(v); v += swz_xor<8>(v); v += swz_xor<16>(v); return half_sum(v); }
__device__ __forceinline__ float wave_max(float v) { v = fmaxf(v, swz_xor<1>(v)); v = fmaxf(v, swz_xor<2>(v)); v = fmaxf(v, swz_xor<4>(v)); v = fmaxf(v, swz_xor<8>(v)); v = fmaxf(v, swz_xor<16>(v)); return half_max(v); }

#define XB_TMO      128
#define XB_XCNT(j)  (256  + 64 * (j))
#define XB_XSUB(j)  (1280 + 64 * (j))
#define XB_XGEN(j)  (2304 + 64 * (j))
#define XB_TOP      3328
#define XB_TOPGEN   3392
#define XCD_BAR_WORDS 3456
#define XB_SPIN_CAP (1u << 18)

__device__ __forceinline__ unsigned xb_ld(unsigned* p)              { return __hip_atomic_load(p, __ATOMIC_RELAXED, __HIP_MEMORY_SCOPE_AGENT); }
__device__ __forceinline__ unsigned xb_add(unsigned* p, unsigned v) { return __hip_atomic_fetch_add(p, v, __ATOMIC_RELAXED, __HIP_MEMORY_SCOPE_AGENT); }
__device__ __forceinline__ unsigned xb_xcc_id() { return (unsigned)__builtin_amdgcn_s_getreg((3 << 11) | 20) & 0xFu; }
#define XB_SPIN(cond, bar) do { unsigned _sp = 0; while (cond) { __builtin_amdgcn_s_sleep(1); \
    if ((++_sp & 255u) == 0u) { if (xb_ld(&(bar)[XB_TMO])) break; if (_sp > XB_SPIN_CAP) { atomicAdd(&(bar)[XB_TMO], 1u); break; } } } } while (0)

struct XcdBarrier {
    unsigned* bar; unsigned x;
    volatile LAS unsigned* st;
};

__device__ __forceinline__ XcdBarrier xcd_barrier_post(unsigned* bar, volatile LAS unsigned* st) {
    XcdBarrier b; b.bar = bar; b.x = xb_xcc_id(); b.st = st;
    if (threadIdx.x == 0) (void)xb_add(&bar[XB_XCNT(b.x)], 1u);
    return b;
}
__device__ __forceinline__ void xcd_barrier_complete(unsigned* bar, unsigned x, unsigned& nloc, unsigned& nx) {
    const unsigned G = gridDim.x * gridDim.y * gridDim.z;
    unsigned sum, cnt, mine, sp = 0u;
    for (;;) {
        sum = 0u; cnt = 0u; mine = 0u;
#pragma unroll
        for (unsigned j = 0; j < 16; ++j) { const unsigned c = xb_ld(&bar[XB_XCNT(j)]); sum += c; cnt += (c > 0u) ? 1u : 0u; mine = (j == x) ? c : mine; }
        if (sum == G) break;
        __builtin_amdgcn_s_sleep(1);
        if ((++sp & 255u) == 0u) { if (xb_ld(&bar[XB_TMO])) break; if (sp > XB_SPIN_CAP) { atomicAdd(&bar[XB_TMO], 1u); break; } }
    }
    nloc = mine > 0u ? mine : 1u; nx = cnt > 0u ? cnt : 1u;
}

__device__ __forceinline__ void xcd_barrier(const XcdBarrier& b) {
    asm volatile("s_waitcnt vmcnt(0)" ::: "memory");
    __syncthreads();
    if (threadIdx.x == 0) {
        unsigned* bar = b.bar;
        __builtin_amdgcn_s_waitcnt(0);
        unsigned nloc = b.st[0], nx = b.st[1];
        if (nloc == 0u) { xcd_barrier_complete(bar, b.x, nloc, nx); b.st[0] = nloc; b.st[1] = nx; }
        const unsigned old = xb_add(&bar[XB_XSUB(b.x)], 1u);
        const unsigned gen = old / nloc;
        if (old + 1u == (gen + 1u) * nloc) {
            __builtin_amdgcn_fence(__ATOMIC_RELEASE, "agent");
            asm volatile("s_waitcnt vmcnt(0)" ::: "memory");
            const unsigned og = xb_add(&bar[XB_TOP], 1u);
            const unsigned tg = og / nx;
            if (og + 1u == (tg + 1u) * nx) xb_add(&bar[XB_TOPGEN], 1u);
            else XB_SPIN(xb_ld(&bar[XB_TOPGEN]) == tg, bar);
            __builtin_amdgcn_fence(__ATOMIC_ACQUIRE, "agent");
            xb_add(&bar[XB_XGEN(b.x)], 1u);
            asm volatile("s_waitcnt vmcnt(0)" ::: "memory");
        } else {
            XB_SPIN(xb_ld(&bar[XB_XGEN(b.x)]) == gen, bar);
            __builtin_amdgcn_fence(__ATOMIC_ACQUIRE, "agent");
            asm volatile("s_waitcnt vmcnt(0)" ::: "memory");
        }
    }
    __syncthreads();
}

struct Args { const float* in[24]; float* out; unsigned char* ws; };

struct Frame {
    unsigned char* lds; unsigned char* ws; unsigned char* ar;
    int tid, lane, wave, G, gw, NGW, bx;
};

__device__ __forceinline__ void tr_item(const float* __restrict__ W, int K, int N, int nblk, bf16* __restrict__ WT, int mode, float* scr, int item, int lane) {
    const int kb = item / nblk, nb = item % nblk, k0 = 64 * kb, n0 = 32 * nb;
    const int nn = n0 + (lane & 31); const bool ok = nn < N;
#pragma unroll 8
    for (int i = 0; i < 32; ++i) { const int kk = 2 * i + (lane >> 5); scr[kk * 33 + (lane & 31)] = ok ? W[(size_t)(k0 + kk) * N + nn] : 0.f; }
    LDS_WAIT();
    const int c = lane & 7;
#pragma unroll
    for (int j = 0; j < 4; ++j) { const int n = (lane >> 3) + 8 * j; const float* s = scr + (8 * c) * 33 + n;
        v4u o; o.x = pk2(s[0 * 33], s[1 * 33]); o.y = pk2(s[2 * 33], s[3 * 33]); o.z = pk2(s[4 * 33], s[5 * 33]); o.w = pk2(s[6 * 33], s[7 * 33]);
        const int gn = n0 + n; int drow = gn;
        if (mode) drow = (gn < FF) ? (gn / 128) * 256 + (gn % 128) : ((gn - FF) / 128) * 256 + 128 + ((gn - FF) % 128);
        *(v4u*)(WT + (size_t)drow * K + k0 + 8 * c) = o; }
    LDS_WAIT();
}
__device__ __forceinline__ void convert_weights(const Frame& F, const float* w_f1in, const float* w_f2in, const float* w_f1out, const float* w_f2out, const float* w_pg, const float* w_pp, const float* w_glain, const float* w_foxin, const float* w_glao, const float* w_foxo, const float* w_kvf, int L, bool with_kvf) {
    float* scr = (float*)(F.lds + F.wave * 16384);
    bf16* Wb = (bf16*)(F.ws + WS_W);
    const int I0 = 16 * 176, I1 = 44 * 32, I4 = 16 * 32, I5 = 4 * 32, I6 = (L < 2) ? 16 * (GLA_INP / 32) : 16 * 64, I7 = 16 * 32, I8 = with_kvf ? 16 * (KVF_NP / 32) : 0;
    const int NIT = 2 * I0 + 2 * I1 + I4 + I5 + I6 + I7 + I8;
    for (int it = F.gw; it < NIT; it += F.NGW) {
        int r = it;
        if (r < I0) { tr_item(w_f1in + (size_t)L * D * 2 * FF, D, 2 * FF, 176, Wb + OW_F1IN, 1, scr, r, F.lane); continue; } r -= I0;
        if (r < I0) { tr_item(w_f2in + (size_t)L * D * 2 * FF, D, 2 * FF, 176, Wb + OW_F2IN, 1, scr, r, F.lane); continue; } r -= I0;
        if (r < I1) { tr_item(w_f1out + (size_t)L * FF * D, FF, D, 32, Wb + OW_F1OUT, 0, scr, r, F.lane); continue; } r -= I1;
        if (r < I1) { tr_item(w_f2out + (size_t)L * FF * D, FF, D, 32, Wb + OW_F2OUT, 0, scr, r, F.lane); continue; } r -= I1;
        if (r < I4) { tr_item(w_pg + (size_t)L * D * D, D, D, 32, Wb + OW_PG, 0, scr, r, F.lane); continue; } r -= I4;
        if (r < I5) { tr_item(w_pp + (size_t)L * PLE * D, PLE, D, 32, Wb + OW_PP, 0, scr, r, F.lane); continue; } r -= I5;
        if (r < I6) { if (L < 2) tr_item(w_glain + (size_t)L * D * GLA_IN, D, GLA_IN, GLA_INP / 32, Wb + OW_MIXIN, 0, scr, r, F.lane);
                      else tr_item(w_foxin + (size_t)(L - 2) * D * 2048, D, 2048, 64, Wb + OW_MIXIN, 0, scr, r, F.lane); continue; } r -= I6;
        if (r < I7) { tr_item((L < 2) ? w_glao + (size_t)L * D * D : w_foxo + (size_t)(L - 2) * D * D, D, D, 32, Wb + OW_MIXO, 0, scr, r, F.lane); continue; } r -= I7;
        tr_item(w_kvf, D, KVF_N, KVF_NP / 32, Wb + OW_KVF, 0, scr, r, F.lane);
    }
}
__device__ __forceinline__ void cvt_rows(const Frame& F, const float* __restrict__ src, bf16* __restrict__ dst, size_t n) {
    const size_t nthr = (size_t)F.G * 512, t0 = (size_t)F.bx * 512 + F.tid;
    for (size_t i = t0 * 8; i < n; i += nthr * 8) {
        const f32x4 a = *(const f32x4*)(src + i), b = *(const f32x4*)(src + i + 4);
        v4u o; o.x = pk2(a[0], a[1]); o.y = pk2(a[2], a[3]); o.z = pk2(b[0], b[1]); o.w = pk2(b[2], b[3]);
        *(v4u*)(dst + i) = o;
    }
}
__device__ __forceinline__ void ln_phase(const Frame& F, const float* __restrict__ g, const float* __restrict__ bta, float* X, bf16* XB) {
    f32x4 gv[4], bv[4];
#pragma unroll
    for (int j = 0; j < 4; ++j) { gv[j] = ((const f32x4*)g)[F.lane + 64 * j]; bv[j] = ((const f32x4*)bta)[F.lane + 64 * j]; }
    for (int m = F.gw; m < M; m += F.NGW) {
        f32x4* xr = (f32x4*)(X + (size_t)m * D) + F.lane;
        f32x4 v[4]; float s = 0.f;
#pragma unroll
        for (int j = 0; j < 4; ++j) { v[j] = xr[64 * j]; s += (v[j][0] + v[j][1]) + (v[j][2] + v[j][3]); }
        const float mean = wave_sum(s) * (1.f / D); float s2 = 0.f;
#pragma unroll
        for (int j = 0; j < 4; ++j) { v[j] = v[j] - mean; s2 += (v[j][0] * v[j][0] + v[j][1] * v[j][1]) + (v[j][2] * v[j][2] + v[j][3] * v[j][3]); }
        const float rstd = 1.f / sqrtf(wave_sum(s2) * (1.f / D) + LN_EPS);
        v2u* o8 = (v2u*)(XB + (size_t)m * D) + F.lane;
#pragma unroll
        for (int j = 0; j < 4; ++j) { const f32x4 y = v[j] * rstd * gv[j] + bv[j]; xr[64 * j] = y; v2u w; w.x = pk2(y[0], y[1]); w.y = pk2(y[2], y[3]); o8[64 * j] = w; }
    }
}
__device__ __forceinline__ void cumsum_phase(const Frame& F, const float* __restrict__ flog, float* __restrict__ cs) {
    float* sh = (float*)F.lds;
    for (int u = F.bx; u < NB * 16; u += F.G) {
        const int b = u >> 4, h = u & 15; const float* src = flog + ((size_t)b * SEQL + (size_t)F.tid * 32) * 16 + h;
        float tot = 0.f;
#pragma unroll 8
        for (int i = 0; i < 32; ++i) tot += src[i * 16];
        __syncthreads();
        sh[F.tid] = tot;
        __syncthreads();
        float pre = 0.f;
        for (int i = 0; i < F.tid; ++i) pre += sh[i];
        float* dst = cs + (size_t)u * SEQL + F.tid * 32;
#pragma unroll 8
        for (int i = 0; i < 32; ++i) { pre += src[i * 16]; dst[i] = pre; }
    }
}
__device__ __forceinline__ void kmax_phase(const Frame& F, const bf16* __restrict__ KS, unsigned* cell) {
    float mx = 0.f;
    for (int m = F.gw; m < M; m += F.NGW) {
        const v4u a = *(const v4u*)(KS + (size_t)m * D + F.lane * 16), b = *(const v4u*)(KS + (size_t)m * D + F.lane * 16 + 8);
        float ss = 0.f;
#pragma unroll
        for (int e = 0; e < 4; ++e) { const float x0 = bflo(a[e]), x1 = bfhi(a[e]), y0 = bflo(b[e]), y1 = bfhi(b[e]); ss += x0 * x0 + x1 * x1 + y0 * y0 + y1 * y1; }
        ss += swz_xor<1>(ss); ss += swz_xor<2>(ss);
        mx = fmaxf(mx, ss);
    }
    mx = wave_max(mx);
    if (F.lane == 0) atomicMax(cell, __float_as_uint(mx));
}
__device__ __forceinline__ unsigned f2bf1(float x) { return pk2(x, 0.f) & 0xffffu; }
#define MFMA32(a, b, c) __builtin_amdgcn_mfma_f32_32x32x16_bf16((a), (b), (c), 0, 0, 0)
#define MFMA16(a, b, c) __builtin_amdgcn_mfma_f32_16x16x32_bf16((a), (b), (c), 0, 0, 0)
__device__ __forceinline__ void gla_prep(const Frame& F, const float* __restrict__ wa2, const float* __restrict__ ba) {
    bf16* GQ = (bf16*)(F.ar + AR_GQ); bf16* GK = (bf16*)(F.ar + AR_GK); const bf16* GV = (const bf16*)(F.ar + AR_GV); const float* GA = (const float*)(F.ar + AR_GA);
    float* GD = (float*)(F.ar + AR_GD); bf16* GKT = (bf16*)(F.ar + AR_GKT); bf16* GVT = (bf16*)(F.ar + AR_GVT);
    float* sa = (float*)F.lds; bf16* sv = (bf16*)(F.lds + 4096);
    const int j = F.tid;
    float w[16];
#pragma unroll
    for (int m = 0; m < 16; ++m) w[m] = wa2[m * 512 + j];
    const float bj = ba[j];
    for (int cu = F.bx; cu < NB * NCH; cu += F.G) {
        const size_t m0 = (size_t)cu * 64;
        __syncthreads();
        if (F.tid < 256) ((f32x4*)sa)[F.tid] = ((const f32x4*)(GA + m0 * 16))[F.tid];
        __syncthreads();
        float cum = 0.f; unsigned kt[32];
#pragma unroll
        for (int r = 0; r < 64; ++r) {
            const f32x4 a0 = ((const f32x4*)sa)[r * 4], a1 = ((const f32x4*)sa)[r * 4 + 1], a2 = ((const f32x4*)sa)[r * 4 + 2], a3 = ((const f32x4*)sa)[r * 4 + 3];
            float z = bj;
            z += a0[0] * w[0] + a0[1] * w[1] + a0[2] * w[2] + a0[3] * w[3];
            z += a1[0] * w[4] + a1[1] * w[5] + a1[2] * w[6] + a1[3] * w[7];
            z += a2[0] * w[8] + a2[1] * w[9] + a2[2] * w[10] + a2[3] * w[11];
            z += a3[0] * w[12] + a3[1] * w[13] + a3[2] * w[14] + a3[3] * w[15];
            cum += pg8::flogsig(z) * 0.0625f;
            const float e = __expf(cum), ei = __expf(-cum);
            const size_t o = (m0 + r) * 512 + j;
            GQ[o] = (bf16)f2bf1(bflo((unsigned)GQ[o]) * e);
            const unsigned kb = f2bf1(bflo((unsigned)GK[o]) * ei);
            GK[o] = (bf16)kb;
            if (r & 1) kt[r >> 1] |= kb << 16; else kt[r >> 1] = kb;
        }
        GD[(size_t)cu * 512 + j] = __expf(cum);
        v4u* kd = (v4u*)(GKT + ((size_t)cu * 512 + j) * 64);
#pragma unroll
        for (int i = 0; i < 8; ++i) { v4u t; t.x = kt[4 * i]; t.y = kt[4 * i + 1]; t.z = kt[4 * i + 2]; t.w = kt[4 * i + 3]; kd[i] = t; }
        for (int h = 0; h < 4; ++h) {
            __syncthreads();
#pragma unroll
            for (int i = 0; i < 4; ++i) { const int q = F.tid + 512 * i, row = q >> 5, cc = q & 31;
                *(v4u*)(sv + row * 264 + cc * 8) = *(const v4u*)(GV + (m0 + row) * 1024 + h * 256 + cc * 8); }
            __syncthreads();
            const int c = F.tid & 255, half = F.tid >> 8;
            unsigned vt[16];
#pragma unroll
            for (int s = 0; s < 16; ++s) vt[s] = (unsigned)sv[(half * 32 + 2 * s) * 264 + c] | ((unsigned)sv[(half * 32 + 2 * s + 1) * 264 + c] << 16);
            v4u* vd = (v4u*)(GVT + ((size_t)cu * 1024 + h * 256 + c) * 64 + half * 32);
#pragma unroll
            for (int i = 0; i < 4; ++i) { v4u t; t.x = vt[4 * i]; t.y = vt[4 * i + 1]; t.z = vt[4 * i + 2]; t.w = vt[4 * i + 3]; vd[i] = t; }
        }
    }
}
__device__ __forceinline__ void gla_scan(const Frame& F) {
    const bf16* GKT = (const bf16*)(F.ar + AR_GKT); const bf16* GVT = (const bf16*)(F.ar + AR_GVT); const float* GD = (const float*)(F.ar + AR_GD); bf16* GST = (bf16*)(F.ar + AR_GST);
    if (F.wave < 4) {
        const int l15 = F.lane & 15, l4 = F.lane >> 4;
        for (int wt = F.bx * 4 + F.wave; wt < 1024; wt += F.G * 4) {
            const int bh = wt >> 7, ib = (wt >> 4) & 7, cb = wt & 15, b = bh >> 2, h = bh & 3;
            const bf16* kp = GKT + ((size_t)b * NCH * 512 + h * 128 + ib * 16 + l15) * 64 + 8 * l4;
            const bf16* vp = GVT + ((size_t)b * NCH * 1024 + h * 256 + cb * 16 + l15) * 64 + 8 * l4;
            const float* dp = GD + (size_t)b * NCH * 512 + h * 128 + ib * 16 + 4 * l4;
            bf16* sp = GST + ((size_t)bh * NCH * 256 + cb * 16 + l15) * 128 + ib * 16 + 4 * l4;
            f32x4 S = {0.f, 0.f, 0.f, 0.f};
            bf16x8 ka[8][2], vb[8][2]; f32x4 dd[8];
#define SC_LOAD(u, n) do { ka[u][0] = *(const bf16x8*)(kp + (size_t)(n) * 32768); ka[u][1] = *(const bf16x8*)(kp + (size_t)(n) * 32768 + 32); \
                           vb[u][0] = *(const bf16x8*)(vp + (size_t)(n) * 65536); vb[u][1] = *(const bf16x8*)(vp + (size_t)(n) * 65536 + 32); \
                           dd[u] = *(const f32x4*)(dp + (size_t)(n) * 512); } while (0)
#pragma unroll
            for (int u = 0; u < 8; ++u) SC_LOAD(u, u);
            for (int n0 = 0; n0 < NCH; n0 += 8) {
#pragma unroll
                for (int u = 0; u < 8; ++u) {
                    const int n = n0 + u;
                    v2u st; st.x = pk2(S[0], S[1]); st.y = pk2(S[2], S[3]);
                    *(v2u*)(sp + (size_t)n * 32768) = st;
                    S = MFMA16(ka[u][0], vb[u][0], S); S = MFMA16(ka[u][1], vb[u][1], S);
                    S = S * dd[u];
                    if (n + 8 < NCH) SC_LOAD(u, n + 8);
                }
            }
#undef SC_LOAD
        }
    }
}
__device__ __forceinline__ void gla_out(const Frame& F, const float* __restrict__ gng, const float* __restrict__ gnb) {
    const bf16* GQ = (const bf16*)(F.ar + AR_GQ); const bf16* GK = (const bf16*)(F.ar + AR_GK); const bf16* GVT = (const bf16*)(F.ar + AR_GVT);
    const bf16* GST = (const bf16*)(F.ar + AR_GST); const bf16* GR = (const bf16*)(F.ar + AR_GR); bf16* OG = (bf16*)(F.ar + AR_GV);
    float* red = (float*)F.lds;
    const int lane = F.lane, r32 = lane & 31, hi = lane >> 5, w = F.wave;
    int par = 0;
    for (int uid = F.bx; uid < NB * NCH * 4; uid += F.G, par ^= 1) {
        const int cu = uid >> 2, h = uid & 3; const size_t m0 = (size_t)cu * 64;
        const int bh = (cu / NCH) * 4 + h, n = cu % NCH;
        f32x16 X00 = {}, X01 = {}, X11 = {};
        const bf16* qb = GQ + (m0 + r32) * 512 + h * 128 + 8 * hi;
        const bf16* kb = GK + (m0 + r32) * 512 + h * 128 + 8 * hi;
#pragma unroll
        for (int ks = 0; ks < 8; ++ks) {
            const bf16x8 q0 = *(const bf16x8*)(qb + ks * 16), q1 = *(const bf16x8*)(qb + 32 * 512 + ks * 16);
            const bf16x8 k0 = *(const bf16x8*)(kb + ks * 16), k1 = *(const bf16x8*)(kb + 32 * 512 + ks * 16);
            X00 = MFMA32(k0, q0, X00); X01 = MFMA32(k0, q1, X01); X11 = MFMA32(k1, q1, X11);
        }
#pragma unroll
        for (int reg = 0; reg < 16; ++reg) { const int sp = (reg & 3) + 8 * (reg >> 2) + 4 * hi; if (sp > r32) { X00[reg] = 0.f; X11[reg] = 0.f; } }
        bf16x8 B00[2], B01[2], B11[2];
#pragma unroll
        for (int sk = 0; sk < 2; ++sk) {
            v4u t;
            t.x = pk2(X00[8 * sk], X00[8 * sk + 1]); t.y = pk2(X00[8 * sk + 2], X00[8 * sk + 3]); t.z = pk2(X00[8 * sk + 4], X00[8 * sk + 5]); t.w = pk2(X00[8 * sk + 6], X00[8 * sk + 7]); B00[sk] = __builtin_bit_cast(bf16x8, t);
            t.x = pk2(X01[8 * sk], X01[8 * sk + 1]); t.y = pk2(X01[8 * sk + 2], X01[8 * sk + 3]); t.z = pk2(X01[8 * sk + 4], X01[8 * sk + 5]); t.w = pk2(X01[8 * sk + 6], X01[8 * sk + 7]); B01[sk] = __builtin_bit_cast(bf16x8, t);
            t.x = pk2(X11[8 * sk], X11[8 * sk + 1]); t.y = pk2(X11[8 * sk + 2], X11[8 * sk + 3]); t.z = pk2(X11[8 * sk + 4], X11[8 * sk + 5]); t.w = pk2(X11[8 * sk + 6], X11[8 * sk + 7]); B11[sk] = __builtin_bit_cast(bf16x8, t);
        }
        f32x16 o0 = {}, o1 = {};
        const bf16* vtp = GVT + ((size_t)cu * 1024 + h * 256 + 32 * w + r32) * 64 + 4 * hi;
#pragma unroll
        for (int stp = 0; stp < 2; ++stp)
#pragma unroll
            for (int sk = 0; sk < 2; ++sk) {
                const v2u lo = *(const v2u*)(vtp + 32 * stp + 16 * sk), hh = *(const v2u*)(vtp + 32 * stp + 16 * sk + 8);
                v4u t; t.x = lo.x; t.y = lo.y; t.z = hh.x; t.w = hh.y; const bf16x8 Av = __builtin_bit_cast(bf16x8, t);
                if (stp == 0) { o0 = MFMA32(Av, B00[sk], o0); o1 = MFMA32(Av, B01[sk], o1); } else { o1 = MFMA32(Av, B11[sk], o1); }
            }
        const bf16* stq = GST + (((size_t)bh * NCH + n) * 256 + 32 * w + r32) * 128 + 8 * hi;
#pragma unroll
        for (int ks = 0; ks < 8; ++ks) {
            const bf16x8 As = *(const bf16x8*)(stq + ks * 16);
            const bf16x8 q0 = *(const bf16x8*)(qb + ks * 16), q1 = *(const bf16x8*)(qb + 32 * 512 + ks * 16);
            o0 = MFMA32(As, q0, o0); o1 = MFMA32(As, q1, o1);
        }
        float s0 = 0.f, q0s = 0.f, s1 = 0.f, q1s = 0.f;
#pragma unroll
        for (int reg = 0; reg < 16; ++reg) { s0 += o0[reg]; q0s += o0[reg] * o0[reg]; s1 += o1[reg]; q1s += o1[reg] * o1[reg]; }
        s0 = half_sum(s0); q0s = half_sum(q0s); s1 = half_sum(s1); q1s = half_sum(q1s);
        if (hi == 0) { float* rp = red + ((par * 8 + w) * 64 + r32) * 2; rp[0] = s0; rp[1] = q0s; rp[64] = s1; rp[65] = q1s; }
        __syncthreads();
        float mean[2], rstd[2];
#pragma unroll
        for (int st = 0; st < 2; ++st) { float ts = 0.f, tq = 0.f;
#pragma unroll
            for (int ww = 0; ww < 8; ++ww) { const float* rp = red + ((par * 8 + ww) * 64 + 32 * st + r32) * 2; ts += rp[0]; tq += rp[1]; }
            mean[st] = ts * (1.f / 256.f); const float var = fmaxf(tq * (1.f / 256.f) - mean[st] * mean[st], 0.f); rstd[st] = 1.f / sqrtf(var + LN_EPS); }
#pragma unroll
        for (int st = 0; st < 2; ++st) {
            const size_t row = m0 + 32 * st + r32;
#pragma unroll
            for (int g = 0; g < 4; ++g) {
                const int gl = h * 256 + 32 * w + 8 * g + 4 * hi;
                const f32x4 gg = *(const f32x4*)(gng + gl), bb = *(const f32x4*)(gnb + gl);
                const v2u rr = *(const v2u*)(GR + row * 1024 + gl);
                const float rv[4] = {bflo(rr.x), bfhi(rr.x), bflo(rr.y), bfhi(rr.y)};
                float y[4];
#pragma unroll
                for (int jj = 0; jj < 4; ++jj) { const float ov = (st == 0) ? o0[4 * g + jj] : o1[4 * g + jj];
                    y[jj] = ((ov - mean[st]) * rstd[st] * gg[jj] + bb[jj]) * (rv[jj] * pg8::fsigmoid(rv[jj])); }
                v2u ow; ow.x = pk2(y[0], y[1]); ow.y = pk2(y[2], y[3]);
                *(v2u*)(OG + row * 1024 + gl) = ow;
            }
        }
    }
}
__global__ void __launch_bounds__(NWAVES * 64, 2) yoco_fwd(Args a) {
    extern __shared__ __attribute__((aligned(16))) unsigned char lds_raw[];
    cg::grid_group grid = cg::this_grid();
    Frame F;
    F.lds = lds_raw; F.ws = a.ws; F.ar = a.ws + WS_AR;
    F.tid = threadIdx.x; F.lane = F.tid & 63; F.wave = __builtin_amdgcn_readfirstlane(F.tid >> 6); F.bx = blockIdx.x;
    F.G = gridDim.x; F.gw = blockIdx.x * NWAVES + F.wave; F.NGW = F.G * NWAVES;
    {
        const float** const tab0 = (const float**)(a.ws + 64);
        if (F.tid == 0 && blockIdx.x == 0) {
            tab0[0] = a.in[0]; tab0[1] = a.in[1]; tab0[2] = a.in[2]; tab0[3] = a.in[3]; tab0[4] = a.in[4]; tab0[5] = a.in[5]; tab0[6] = a.in[6]; tab0[7] = a.in[7];
            tab0[8] = a.in[8]; tab0[9] = a.in[9]; tab0[10] = a.in[10]; tab0[11] = a.in[11]; tab0[12] = a.in[12]; tab0[13] = a.in[13]; tab0[14] = a.in[14]; tab0[15] = a.in[15];
            *(unsigned*)(a.ws + 1024) = 0u;
            tab0[16] = a.in[16]; tab0[17] = a.in[17]; tab0[18] = a.in[18]; tab0[19] = a.in[19]; tab0[20] = a.in[20]; tab0[21] = a.in[21]; tab0[22] = a.in[22]; tab0[23] = a.in[23];
        }
    }
    if (blockIdx.x == 0) for (int i = threadIdx.x; i < XCD_BAR_WORDS; i += NWAVES * 64) ((unsigned*)(a.ws + 4096))[i] = 0u;
#define TAB(i) (tab[(i)])
    convert_weights(F, a.in[2], a.in[18], a.in[3], a.in[19], a.in[20], a.in[21], a.in[6], a.in[14], a.in[11], a.in[15], a.in[12], 0, true);
    cvt_rows(F, a.in[0], (bf16*)(a.ws + WS_XB), (size_t)M * D);
    grid.sync();

    volatile int* const ctl = (volatile int*)(lds_raw + LDS_BYTES - 16);
    volatile LAS unsigned* const bst = (volatile LAS unsigned*)((LAS unsigned char*)lds_raw + LDS_BYTES - 32);
    if (threadIdx.x == 0) { ctl[0] = 0; bst[0] = 0u; bst[1] = 0u; }
    __syncthreads();
    (void)xcd_barrier_post((unsigned*)(a.ws + 4096), bst);
    for (;;) {
        {
            const int step = __builtin_amdgcn_readfirstlane(ctl[0]);
            if (step >= 49) break;
            const int L = (step < 13) ? 0 : (step < 26 ? 1 : (step < 38 ? 2 : 3));
            const int st = step - ((L == 0) ? 0 : (L == 1 ? 13 : (L == 2 ? 26 : 38)));
            const unsigned long long prog = (L < 2) ? 0xCBA9876543210ull : (L == 2 ? 0xCBA987FE210Dull : 0xCBA987FE210ull);
            const int code = (int)((prog >> (4 * st)) & 15ull);
#define STEP_FRAME() \
            const unsigned char* ka = (const unsigned char*)__builtin_amdgcn_kernarg_segment_ptr(); \
            unsigned char* ws = *(unsigned char* const volatile*)(ka + 25 * 8); float* X = *(float* const volatile*)(ka + 24 * 8); \
            F.lds = lds_raw; F.ws = ws; F.ar = ws + WS_AR; \
            { int t_ = threadIdx.x, b_ = blockIdx.x, g_ = gridDim.x; asm volatile("" : "+v"(t_), "+s"(b_), "+s"(g_)); F.tid = t_; F.bx = b_; F.G = g_; } \
            F.lane = F.tid & 63; F.wave = __builtin_amdgcn_readfirstlane(F.tid >> 6); \
            F.gw = F.bx * NWAVES + F.wave; F.NGW = F.G * NWAVES; \
            LAS unsigned char* lds3 = (LAS unsigned char*)lds_raw; \
            const float** const tab = (const float**)(ws + 64); \
            bf16* const Wb = (bf16*)(ws + WS_W); bf16* const XB = (bf16*)(ws + WS_XB); bf16* const HB = (bf16*)(F.ar + AR_H); bf16* const PB = (bf16*)(F.ar + AR_PB); bf16* const PLEB = (bf16*)(F.ar + AR_PLE); \
            bf16* const KSH = (bf16*)(F.ar + AR_KSH); bf16* const VSH = (bf16*)(F.ar + AR_VSH); float* const CSH = (float*)(F.ar + AR_CSH); float* const FLOG = (float*)(F.ar + AR_FLOG); \
            (void)lds3; (void)tab; (void)Wb; (void)XB; (void)HB; (void)PB; (void)PLEB; (void)KSH; (void)VSH; (void)CSH; (void)FLOG; (void)X;
            switch (code) {
#ifndef NO_SWIGLU
            case 0: case 10: { STEP_FRAME()
#ifndef NO_PLE
                if (code == 10) {
                    pg8::Gemm g{XB, Wb + OW_PG, M, D, D}; pg8::StaticOrder S; S.init(M, D, F.G, F.bx);
                    pg8::EpiPle E{PLEB};
                    pg8::gemm_phase<pg8::EpiPle, pg8::StaticOrder, PG8_ALIGN, PG8_SP2>(lds3, g, S, E);
                }
#endif
                pg8::Gemm g{XB, Wb + (code == 0 ? OW_F1IN : OW_F2IN), M, 2 * FF, D}; pg8::StaticOrder S; S.init(M, 2 * FF, F.G, F.bx);
                pg8::EpiSwiGLU E{HB, FF};
#ifdef PROBE_DOUBLE_SWIGLU
                for (int rep_ = 0; rep_ < 2; ++rep_)
#endif
                pg8::gemm_phase<pg8::EpiSwiGLU, pg8::StaticOrder, PG8_ALIGN, PG8_SP2>(lds3, g, S, E);
            } break;
#endif
#ifndef NO_RES
            case 1: case 7: case 11: { STEP_FRAME()
                const bf16* A = (code == 7) ? ((L < 2) ? (const bf16*)(F.ar + AR_GV) : (const bf16*)(F.ar + AR_FQ)) : HB;
                const bf16* Wt = Wb + (code == 1 ? OW_F1OUT : (code == 7 ? OW_MIXO : OW_F2OUT));
                const int K = (code == 7) ? D : FF;
                const float* base = (L == 0 && code == 1) ? TAB(0) : X;
                pg8::Gemm g{A, Wt, M, D, K}; pg8::StaticOrder S; S.init(M, D, F.G, F.bx);
                pg8::EpiRes E{base, X, (code == 11) ? PLEB : nullptr, DN_ALPHA, (code == 7) ? 1.f : 0.5f};
                pg8::gemm_phase<pg8::EpiRes, pg8::StaticOrder, PG8_ALIGN, PG8_SP2>(lds3, g, S, E);
            } break;
#endif
#ifndef NO_LN
            case 2: case 8: case 12: { STEP_FRAME()
                const int gi = (code == 2) ? 4 : (code == 8 ? 16 : 22);
                ln_phase(F, TAB(gi) + L * D, TAB(gi + 1) + L * D, X, XB);
                if (code == 2 && L == 2) { cumsum_phase(F, FLOG, CSH); kmax_phase(F, KSH, (unsigned*)(ws + 1024)); }
                if (code == 8) cvt_rows(F, TAB(1) + (size_t)L * M * PLE, PB, (size_t)M * PLE);
                if (code == 12 && L + 1 < DEPTH) convert_weights(F, TAB(2), TAB(18), TAB(3), TAB(19), TAB(20), TAB(21), TAB(6), TAB(14), TAB(11), TAB(15), TAB(12), L + 1, false);
            } break;
#endif
#ifndef NO_SPLIT
            case 3: case 9: case 13: case 14: { STEP_FRAME()
                const int mode = (code == 3) ? 0 : (code == 9 ? 1 : (code == 13 ? 2 : 3));
                const pg8::Gemm g{(code == 9) ? PB : XB, Wb + (code == 9 ? OW_PP : (code == 13 ? OW_KVF : OW_MIXIN)), M, (code == 3) ? GLA_INP : (code == 9 ? D : (code == 13 ? KVF_NP : 2048)), (code == 9) ? PLE : D};
                const pg8::EpiSplit E{F.ar, mode, TAB(13)};
                pg8::StaticOrder S; S.init(g.M, g.N, F.G, F.bx);
                pg8::gemm_phase<pg8::EpiSplit, pg8::StaticOrder, PG8_ALIGN, PG8_SP2>(lds3, g, S, E);
            } break;
#endif
#ifndef NO_PREP
            case 4: { STEP_FRAME() gla_prep(F, TAB(7) + (size_t)L * 16 * 512, TAB(8) + L * 512); } break;
#endif
#ifndef NO_SCAN
            case 5: { STEP_FRAME() gla_scan(F);
#ifdef PROBE_DOUBLE_SCAN
                gla_scan(F);
#endif
            } break;
#endif
#ifndef NO_OUT
            case 6: { STEP_FRAME() gla_out(F, TAB(9) + L * D, TAB(10) + L * D);
#ifdef PROBE_DOUBLE_OUT
                gla_out(F, TAB(9) + L * D, TAB(10) + L * D);
#endif
            } break;
#endif
#ifndef NO_ATTN
            case 15: { STEP_FRAME()
                const attn_body::AttnTensors AT{(const attn_body::bf16*)(F.ar + AR_FQ), (const attn_body::bf16*)KSH, (const attn_body::bf16*)VSH, (attn_body::bf16*)(F.ar + AR_FQ),
                                                (const attn_body::bf16*)(F.ar + AR_FG), CSH, sqrtf(*(const float*)(ws + 1024))};
                const attn_body::StaticOrder S((int)F.G, F.bx);
                attn_body::attn_phase<attn_body::StaticOrder>((char*)lds_raw, AT, S);
            } break;
#endif
            default: break;
            }
        }
        if (threadIdx.x == 0) ctl[0] = ctl[0] + 1;
#ifdef USE_CG_SYNC
        grid.sync();
#else
        { const unsigned char* ka2 = (const unsigned char*)__builtin_amdgcn_kernarg_segment_ptr();
          XcdBarrier xb; xb.bar = (unsigned*)(*(unsigned char* const volatile*)(ka2 + 25 * 8) + 4096); xb.x = xb_xcc_id(); xb.st = (volatile LAS unsigned*)((LAS unsigned char*)lds_raw + LDS_BYTES - 32);
          xcd_barrier(xb); }
#endif
#ifdef PROBE_DOUBLE_SYNC
        grid.sync(); grid.sync(); grid.sync(); grid.sync();
#endif
    }
}

extern "C" void kernel_launch(void* const* d_in, const int* in_sizes, int n_in, void* d_out, int out_size, void* d_ws, size_t ws_size, hipStream_t stream) {
    static int grid = 0;
    if (grid == 0) {
        if (n_in != 24 || out_size != M * D || ws_size < WS_END) { fprintf(stderr, "kernel_launch: unexpected shapes (n_in %d, out %d, ws %zu)\n", n_in, out_size, ws_size); grid = -1; return; }
        int dev = 0, cus = 0, per_cu = 0;
        if (hipGetDevice(&dev) != hipSuccess || hipDeviceGetAttribute(&cus, hipDeviceAttributeMultiprocessorCount, dev) != hipSuccess) { grid = -1; return; }
        if (hipFuncSetAttribute((const void*)yoco_fwd, hipFuncAttributeMaxDynamicSharedMemorySize, LDS_BYTES) != hipSuccess) { fprintf(stderr, "kernel_launch: hipFuncSetAttribute failed\n"); grid = -1; return; }
        if (hipOccupancyMaxActiveBlocksPerMultiprocessor(&per_cu, (const void*)yoco_fwd, NWAVES * 64, LDS_BYTES) != hipSuccess || per_cu < 1) per_cu = 1;
        (void)hipGetLastError();
        grid = cus * per_cu;
    }
    if (grid < 0) return;
    Args a{};
    for (int i = 0; i < 24; ++i) a.in[i] = (const float*)d_in[i];
    a.out = (float*)d_out; a.ws = (unsigned char*)d_ws;
    void* args[] = {&a};
    const hipError_t e = hipLaunchCooperativeKernel((const void*)yoco_fwd, dim3(grid), dim3(NWAVES * 64), args, LDS_BYTES, stream);
    if (e != hipSuccess) fprintf(stderr, "kernel_launch: cooperative launch failed: %s (grid %d)\n", hipGetErrorString(e), grid);
}
```

```cpp
#include <hip/hip_runtime.h>
#include <hip/hip_cooperative_groups.h>
#include <cstdio>
#include <cstdint>
namespace cg = cooperative_groups;
namespace pg8 {
#define PG8_LAS __attribute__((address_space(3)))
typedef unsigned short bf16_t;
typedef short bf16x8 __attribute__((ext_vector_type(8)));
typedef float f32x4 __attribute__((ext_vector_type(4)));
typedef unsigned u32x4 __attribute__((ext_vector_type(4)));
constexpr int BM = 256, BK = 64, HALF = 128, HTB = HALF * BK * 2  , STAGE_BYTES = 8 * HTB, NXCD = 8, WGM = 8;

__host__ __device__ __forceinline__ int lds_byte(int r, int c) { const int st = (r >> 4) * 2 + (c >> 5), rr = r & 15, cc = c & 31, ob = rr * 64 + cc * 2; return st * 1024 + (ob ^ (((ob >> 9) & 1) << 5)); }
__host__ __device__ __forceinline__ void stage_rc(int b, int& R, int& C) { const int st = b / 1024, sb = b % 1024, swz = sb ^ (((sb >> 9) & 1) << 5); R = (st >> 1) * 16 + swz / 64; C = (st & 1) * 32 + (swz % 64) / 2; }
__host__ __device__ __forceinline__ int perm32(int rho) { const int n = rho >> 4, i = rho & 15; return 8 * (i >> 2) + 4 * n + (i & 3); }

struct Unit { int pm, pn; };
struct Gemm { const bf16_t* A; const bf16_t* Bt; int M, N, K; };

struct StaticOrder {
    int nM, nN, nwg, G, c;
    __host__ __device__ void init(int M, int N, int G_, int c_) { nM = M / BM; nN = N / BM; nwg = nM * nN; G = G_; c = c_; }
    __host__ __device__ bool next(int i, Unit& u) const {
        const long L = (long)i * G + c; if (L >= nwg) return false;
        int wgid = (int)L; { const int q = nwg / NXCD, r = nwg % NXCD, xcd = wgid % NXCD, off = wgid / NXCD; wgid = (xcd < r ? xcd * (q + 1) : r * (q + 1) + (xcd - r) * q) + off; }
        const int nig = WGM * nN, gid = wgid / nig, fm = gid * WGM, gsz = (nM - fm) < WGM ? (nM - fm) : WGM;
        u.pm = fm + ((wgid % nig) % gsz); u.pn = (wgid % nig) / gsz; return true;
    }
    __device__ __forceinline__ void a_ready(const Unit&) const {}
    __device__ __forceinline__ void done(const Unit&) const {}
};

__device__ __forceinline__ unsigned cvt_pk_bf16(float lo, float hi) { unsigned r; asm volatile("v_cvt_pk_bf16_f32 %0, %1, %2" : "=v"(r) : "v"(lo), "v"(hi)); return r; }
__device__ __forceinline__ float fsigmoid(float x) { return __builtin_amdgcn_rcpf(1.f + __builtin_amdgcn_exp2f(-1.4426950408889634f * x)); }
__device__ __forceinline__ float bf_lo(unsigned w) { return __uint_as_float(w << 16); }
__device__ __forceinline__ float bf_hi(unsigned w) { return __uint_as_float(w & 0xffff0000u); }
__device__ __forceinline__ float flogsig(float z) { return fminf(z, 0.f) - __logf(1.f + __expf(-fabsf(z))); }
typedef unsigned u32x2 __attribute__((ext_vector_type(2)));
typedef float f32x2 __attribute__((ext_vector_type(2)));
#define EPI_IDS() { int t_ = threadIdx.x; asm volatile("" : "+v"(t_)); const int l_ = t_ & 63, w_ = __builtin_amdgcn_readfirstlane(t_ >> 6); wr = w_ >> 2; wc = w_ & 3; fr = l_ & 15; fq = l_ >> 4; }


struct EpiSwiGLU {
    static constexpr bool PERM = true, AFTER_DRAIN = false;
    bf16_t* H; int ldh;
    __device__ __forceinline__ void operator()(const f32x4 (&acc)[2][2][4][2], const Unit& u, int wr, int wc, int fr, int fq) const {
        EPI_IDS();
        const int row0 = u.pm * BM + wr * 64 + fr, col0 = u.pn * HALF + wc * 32 + 8 * fq;
#pragma unroll
        for (int ai = 0; ai < 2; ++ai)
#pragma unroll
            for (int m = 0; m < 4; ++m) {
                bf16_t* p = H + (size_t)(row0 + ai * HALF + m * 16) * ldh + col0;
                const f32x4 g0 = acc[ai][0][m][0], g1 = acc[ai][0][m][1], u0 = acc[ai][1][m][0], u1 = acc[ai][1][m][1];
                float h[8];
#pragma unroll
                for (int j = 0; j < 4; ++j) { h[j] = g0[j] * fsigmoid(g0[j]) * u0[j]; h[4 + j] = g1[j] * fsigmoid(g1[j]) * u1[j]; }
                u32x4 w; w.x = cvt_pk_bf16(h[0], h[1]); w.y = cvt_pk_bf16(h[2], h[3]); w.z = cvt_pk_bf16(h[4], h[5]); w.w = cvt_pk_bf16(h[6], h[7]);
                *(u32x4*)p = w;
            }
    }
};
struct EpiRes {
    static constexpr bool PERM = false, AFTER_DRAIN = false;
    const float* base; float* out; const bf16_t* add; float alpha, s; const float* st; const float* g; const float* b;
    __device__ __forceinline__ void operator()(const f32x4 (&acc)[2][2][4][2], const Unit& u, int wr, int wc, int fr, int fq) const {
        EPI_IDS();
        const int row0 = u.pm * BM + wr * 64 + fr, col0 = u.pn * BM + wc * 32 + 4 * fq;
#pragma unroll
        for (int ai = 0; ai < 2; ++ai)
#pragma unroll
            for (int m = 0; m < 4; ++m) {
                const int row = row0 + ai * HALF + m * 16;
                const size_t off = (size_t)row * 1024 + col0;
                float mean = 0.f, rstd = 1.f;
                if (st) { const f32x2 sv = *(const f32x2*)(st + 2 * row); mean = sv.x; rstd = sv.y; }
#pragma unroll
                for (int bj = 0; bj < 2; ++bj)
#pragma unroll
                    for (int n = 0; n < 2; ++n) {
                        const size_t o = off + bj * HALF + n * 16;
                        f32x4 x = *(const f32x4*)(base + o);
                        if (st) { const int c = col0 + bj * HALF + n * 16; const f32x4 gg = *(const f32x4*)(g + c), bb = *(const f32x4*)(b + c); x = (x - mean) * rstd * gg + bb; }
                        f32x4 v = x * alpha + acc[ai][bj][m][n] * s;
                        if (add) { const u32x2 a = *(const u32x2*)(add + o); v[0] += bf_lo(a.x); v[1] += bf_hi(a.x); v[2] += bf_lo(a.y); v[3] += bf_hi(a.y); }
                        *(f32x4*)(out + o) = v;
                    }
            }
    }
};
struct EpiSplit {
    static constexpr bool PERM = true, AFTER_DRAIN = false;
    unsigned char* ar; int mode; const float* tbias;
    __device__ __forceinline__ void operator()(const f32x4 (&acc)[2][2][4][2], const Unit& u, int wr, int wc, int fr, int fq) const {
        EPI_IDS();
        const int pn = u.pn; const int row0 = u.pm * BM + wr * 64 + fr;
        const int tail_tile = (mode == 0) ? 12 : (mode == 2 ? 8 : -1);
        if (pn == tail_tile) {
            float* tail = (float*)(ar + ((mode == 0) ? (size_t)192 << 20 : (size_t)474 << 20));
            if (wc == 0 && fq < 2) {
#pragma unroll
                for (int ai = 0; ai < 2; ++ai)
#pragma unroll
                    for (int m = 0; m < 4; ++m)
#pragma unroll
                        for (int n = 0; n < 2; ++n) {
                            f32x4 v = acc[ai][0][m][n]; const int c = 8 * fq + 4 * n;
                            if (mode == 2) {
#pragma unroll
                                for (int j = 0; j < 4; ++j) v[j] = flogsig(v[j] + tbias[c + j]);
                            }
                            *(f32x4*)(tail + (size_t)(row0 + ai * HALF + m * 16) * 16 + c) = v;
                        }
            }
            return;
        }
        size_t boff; int ld, tb; float sc = 1.f;
        if (mode == 0) { if (pn < 2) { boff = 0; ld = 512; tb = 0; sc = 0.08838834764831845f; } else if (pn < 4) { boff = (size_t)32 << 20; ld = 512; tb = 2; } else if (pn < 8) { boff = (size_t)64 << 20; ld = 1024; tb = 4; } else { boff = (size_t)128 << 20; ld = 1024; tb = 8; } }
        else if (mode == 1) { boff = (size_t)280 << 20; ld = 1024; tb = 0; }
        else if (mode == 2) { if (pn < 4) { boff = (size_t)344 << 20; tb = 0; } else { boff = (size_t)408 << 20; tb = 4; } ld = 1024; }
        else { if (pn < 4) { boff = 0; tb = 0; sc = 0.125f * 1.4426950408889634f; } else { boff = (size_t)64 << 20; tb = 4; } ld = 1024; }
        bf16_t* base = (bf16_t*)(ar + boff);
        const int col0 = (pn - tb) * BM + wc * 32 + 8 * fq;
#pragma unroll
        for (int ai = 0; ai < 2; ++ai)
#pragma unroll
            for (int m = 0; m < 4; ++m) {
                bf16_t* rowp = base + (size_t)(row0 + ai * HALF + m * 16) * ld + col0;
#pragma unroll
                for (int bj = 0; bj < 2; ++bj) {
                    const f32x4 v0 = acc[ai][bj][m][0] * sc, v1 = acc[ai][bj][m][1] * sc;
                    u32x4 w; w.x = cvt_pk_bf16(v0[0], v0[1]); w.y = cvt_pk_bf16(v0[2], v0[3]); w.z = cvt_pk_bf16(v1[0], v1[1]); w.w = cvt_pk_bf16(v1[2], v1[3]);
                    *(u32x4*)(rowp + bj * HALF) = w;
                }
            }
    }
};
struct EpiPle {
    static constexpr bool PERM = true, AFTER_DRAIN = false;
    bf16_t* P;
    __device__ __forceinline__ void operator()(const f32x4 (&acc)[2][2][4][2], const Unit& u, int wr, int wc, int fr, int fq) const {
        EPI_IDS();
        const int row0 = u.pm * BM + wr * 64 + fr, col0 = u.pn * BM + wc * 32 + 8 * fq;
#pragma unroll
        for (int ai = 0; ai < 2; ++ai)
#pragma unroll
            for (int m = 0; m < 4; ++m) {
                bf16_t* rowp = P + (size_t)(row0 + ai * HALF + m * 16) * 1024 + col0;
#pragma unroll
                for (int bj = 0; bj < 2; ++bj) {
                    const u32x4 pv = *(const u32x4*)(rowp + bj * HALF);
                    const f32x4 v0 = acc[ai][bj][m][0], v1 = acc[ai][bj][m][1];
                    u32x4 w;
                    w.x = cvt_pk_bf16(fsigmoid(v0[0]) * bf_lo(pv.x), fsigmoid(v0[1]) * bf_hi(pv.x));
                    w.y = cvt_pk_bf16(fsigmoid(v0[2]) * bf_lo(pv.y), fsigmoid(v0[3]) * bf_hi(pv.y));
                    w.z = cvt_pk_bf16(fsigmoid(v1[0]) * bf_lo(pv.z), fsigmoid(v1[1]) * bf_hi(pv.z));
                    w.w = cvt_pk_bf16(fsigmoid(v1[2]) * bf_lo(pv.w), fsigmoid(v1[3]) * bf_hi(pv.w));
                    *(u32x4*)(rowp + bj * HALF) = w;
                }
            }
    }
};

template <class Epi, class Sched, bool ALIGN_EPI = false, bool SP2 = false>
__device__ __forceinline__ void gemm_phase(PG8_LAS unsigned char* lds, const Gemm g, const Sched& S, const Epi& E) {
    int tid = threadIdx.x; asm volatile("" : "+v"(tid)); const int wid = __builtin_amdgcn_readfirstlane(tid >> 6), lane = tid & 63, wr = wid >> 2, wc = wid & 3, fr = lane & 15, fq = lane >> 4;
    const int K = g.K, nt = K / BK;
    unsigned voffA[2], voffB[2];
#pragma unroll
    for (int i = 0; i < 2; ++i) { int R, C; stage_rc(tid * 16 + i * 8192, R, C); const int Rb = Epi::PERM ? ((R & ~31) + perm32(R & 31)) : R;
        voffA[i] = (unsigned)(R * K + C) * 2u; voffB[i] = (unsigned)(Rb * K + C) * 2u; }
    const size_t kstep = (size_t)(BK * 2);
    const size_t hstep = (size_t)HALF * K * 2;
    const size_t tstep = 2 * hstep;
    const unsigned ldsw = (unsigned)wid * 1024u;
    const int aoff = lds_byte(wr * 64 + fr, fq * 8), boff = lds_byte(wc * 32 + fr, fq * 8);
#define PG8_SA(b, h) (((b) * 2 + (h)) * HTB)
#define PG8_SB(b, h) ((4 + (b) * 2 + (h)) * HTB)
#define PG8_STAGE(bufoff, gbase, voff) do { _Pragma("unroll") for (int _i = 0; _i < 2; ++_i) \
        __builtin_amdgcn_global_load_lds((const unsigned*)((const char*)(gbase) + (voff)[_i]), (PG8_LAS unsigned*)(lds + (bufoff) + ldsw + _i * 8192), 16, 0, 0); } while (0)
#define PG8_LDA(dst, b, h) do { _Pragma("unroll") for (int m = 0; m < 4; ++m) _Pragma("unroll") for (int k = 0; k < 2; ++k) dst[m][k] = *(const PG8_LAS bf16x8*)(lds + PG8_SA(b, h) + aoff + m * 2048 + k * 1024); } while (0)
#define PG8_LDB(dst, b, h) do { _Pragma("unroll") for (int n = 0; n < 2; ++n) _Pragma("unroll") for (int k = 0; k < 2; ++k) dst[n][k] = *(const PG8_LAS bf16x8*)(lds + PG8_SB(b, h) + boff + n * 2048 + k * 1024); } while (0)
#define PG8_MMA(ai, bj, At, Bt) do { __builtin_amdgcn_s_setprio(1); _Pragma("unroll") for (int m = 0; m < 4; ++m) _Pragma("unroll") for (int n = 0; n < 2; ++n) _Pragma("unroll") for (int k = 0; k < 2; ++k) \
        acc[ai][bj][m][n] = __builtin_amdgcn_mfma_f32_16x16x32_bf16(Bt[n][k], At[m][k], acc[ai][bj][m][n], 0, 0, 0); __builtin_amdgcn_s_setprio(0); } while (0)
#define PG8_WAIT_V(n) asm volatile("s_waitcnt vmcnt(" #n ")" ::: "memory")
#define PG8_WAIT_L(n) asm volatile("s_waitcnt lgkmcnt(" #n ")" ::: "memory")
#define PG8_BAR __builtin_amdgcn_s_barrier()
#define PG8_SCHED __builtin_amdgcn_sched_barrier(0)
    Unit cur, nxt; int ui = 0;
    if (!S.next(0, cur)) return;
    f32x4 acc[2][2][4][2];
#pragma unroll
    for (int a = 0; a < 2; ++a)
#pragma unroll
        for (int b = 0; b < 2; ++b)
#pragma unroll
            for (int m = 0; m < 4; ++m)
#pragma unroll
                for (int n = 0; n < 2; ++n) acc[a][b][m][n] = (f32x4){0.f, 0.f, 0.f, 0.f};
    bf16x8 At[4][2], B0[2][2], B1[2][2];
    const char* cA = (const char*)g.A + (size_t)cur.pm * tstep; const char* cB = (const char*)g.Bt + (size_t)cur.pn * tstep;
    S.a_ready(cur);
    if constexpr (SP2) {
        PG8_STAGE(PG8_SB(0, 0), cB, voffB); PG8_STAGE(PG8_SB(0, 1), cB + hstep, voffB); PG8_STAGE(PG8_SA(0, 0), cA, voffA); PG8_STAGE(PG8_SA(0, 1), cA + hstep, voffA);
        if (wr == 1) PG8_BAR;
        PG8_WAIT_V(2); PG8_BAR;
        PG8_STAGE(PG8_SB(1, 0), cB + kstep, voffB); PG8_STAGE(PG8_SA(1, 0), cA + kstep, voffA); PG8_STAGE(PG8_SB(1, 1), cB + hstep + kstep, voffB);
        PG8_WAIT_V(6); PG8_BAR;
    } else {
        PG8_STAGE(PG8_SB(0, 0), cB, voffB); PG8_STAGE(PG8_SA(0, 0), cA, voffA); PG8_STAGE(PG8_SB(0, 1), cB + hstep, voffB); PG8_STAGE(PG8_SA(0, 1), cA + hstep, voffA);
        if (wr == 1) PG8_BAR;
        PG8_WAIT_V(4); PG8_BAR;
        PG8_STAGE(PG8_SB(1, 0), cB + kstep, voffB); PG8_STAGE(PG8_SA(1, 0), cA + kstep, voffA); PG8_STAGE(PG8_SB(1, 1), cB + hstep + kstep, voffB);
        PG8_WAIT_V(6); PG8_BAR;
    }
    for (;;) {
        const bool has_next = S.next(ui + 1, nxt);
        const char* nA = has_next ? (const char*)g.A + (size_t)nxt.pm * tstep : cA; const char* nB = has_next ? (const char*)g.Bt + (size_t)nxt.pn * tstep : cB;
        for (int t = 0; t < nt; t += 2) {
            const bool last = (t == nt - 2);
            const char* a1 = cA + (size_t)(t + 1) * kstep;
            const char* a2 = last ? nA : cA + (size_t)(t + 2) * kstep; const char* b2 = last ? nB : cB + (size_t)(t + 2) * kstep;
            const char* a3 = a2 + kstep; const char* b3 = b2 + kstep;
            if (last && has_next) S.a_ready(nxt);
            if constexpr (SP2) {
            PG8_LDB(B0, 0, 0); PG8_LDB(B1, 0, 1); PG8_SCHED; PG8_LDA(At, 0, 0); PG8_STAGE(PG8_SA(1, 1), a1 + hstep, voffA);
            PG8_WAIT_V(8); PG8_WAIT_L(0); PG8_BAR; PG8_MMA(0, 0, At, B0); PG8_MMA(0, 1, At, B1); PG8_BAR; PG8_SCHED;
            PG8_LDA(At, 0, 1); PG8_STAGE(PG8_SB(0, 0), b2, voffB); PG8_STAGE(PG8_SB(0, 1), b2 + hstep, voffB); PG8_STAGE(PG8_SA(0, 0), a2, voffA);
            PG8_WAIT_V(8); PG8_WAIT_L(0); PG8_BAR; PG8_MMA(1, 0, At, B0); PG8_MMA(1, 1, At, B1); PG8_BAR; PG8_SCHED;
            PG8_LDB(B0, 1, 0); PG8_LDB(B1, 1, 1); PG8_SCHED; PG8_LDA(At, 1, 0); PG8_STAGE(PG8_SA(0, 1), a2 + hstep, voffA);
            PG8_WAIT_V(8); PG8_WAIT_L(0); PG8_BAR; PG8_MMA(0, 0, At, B0); PG8_MMA(0, 1, At, B1); PG8_BAR; PG8_SCHED;
            PG8_LDA(At, 1, 1); PG8_STAGE(PG8_SB(1, 0), b3, voffB); PG8_STAGE(PG8_SB(1, 1), b3 + hstep, voffB); PG8_STAGE(PG8_SA(1, 0), a3, voffA);
            PG8_WAIT_V(8); PG8_WAIT_L(0); PG8_BAR; PG8_MMA(1, 0, At, B0); PG8_MMA(1, 1, At, B1); PG8_BAR; PG8_SCHED;
            } else {
            PG8_LDB(B0, 0, 0); PG8_SCHED; PG8_LDA(At, 0, 0); PG8_STAGE(PG8_SA(1, 1), a1 + hstep, voffA);
            PG8_WAIT_L(8); PG8_BAR; PG8_WAIT_L(0); PG8_MMA(0, 0, At, B0); PG8_BAR; PG8_SCHED;
            PG8_LDB(B1, 0, 1); PG8_STAGE(PG8_SB(0, 0), b2, voffB);
            PG8_BAR; PG8_WAIT_L(0); PG8_MMA(0, 1, At, B1); PG8_BAR;
            PG8_LDA(At, 0, 1); PG8_STAGE(PG8_SA(0, 0), a2, voffA);
            PG8_BAR; PG8_WAIT_L(0); PG8_MMA(1, 0, At, B0); PG8_BAR; PG8_SCHED;
            PG8_STAGE(PG8_SB(0, 1), b2 + hstep, voffB);
            PG8_WAIT_V(6); PG8_BAR; PG8_MMA(1, 1, At, B1); PG8_BAR;
            PG8_LDB(B0, 1, 0); PG8_SCHED; PG8_LDA(At, 1, 0); PG8_STAGE(PG8_SA(0, 1), a2 + hstep, voffA);
            PG8_WAIT_L(8); PG8_BAR; PG8_WAIT_L(0); PG8_MMA(0, 0, At, B0); PG8_BAR; PG8_SCHED;
            PG8_LDB(B1, 1, 1); PG8_STAGE(PG8_SB(1, 0), b3, voffB);
            PG8_BAR; PG8_WAIT_L(0); PG8_MMA(0, 1, At, B1); PG8_BAR;
            PG8_LDA(At, 1, 1); PG8_STAGE(PG8_SA(1, 0), a3, voffA);
            PG8_BAR; PG8_WAIT_L(0); PG8_MMA(1, 0, At, B0); PG8_BAR; PG8_SCHED;
            PG8_STAGE(PG8_SB(1, 1), b3 + hstep, voffB);
            PG8_WAIT_V(6); PG8_BAR; PG8_MMA(1, 1, At, B1); PG8_BAR;
            }
        }
        if constexpr (ALIGN_EPI) { if (wr == 0) PG8_BAR; }
        if constexpr (!Epi::AFTER_DRAIN) { E(acc, cur, wr, wc, fr, fq); S.done(cur); }
        if (!has_next) break;
#pragma unroll
        for (int a = 0; a < 2; ++a)
#pragma unroll
            for (int b = 0; b < 2; ++b)
#pragma unroll
                for (int m = 0; m < 4; ++m)
#pragma unroll
                    for (int n = 0; n < 2; ++n) acc[a][b][m][n] = (f32x4){0.f, 0.f, 0.f, 0.f};
        cur = nxt; cA = nA; cB = nB; ++ui;
        if constexpr (ALIGN_EPI) { if (wr == 1) PG8_BAR; }
    }
    PG8_WAIT_V(0);
    if constexpr (!ALIGN_EPI) { if (wr == 0) PG8_BAR; }
    PG8_BAR;
    if constexpr (Epi::AFTER_DRAIN) { E.fused(acc, cur, wr, wc, fr, fq, lds, wid, lane); S.done(cur); }
#undef PG8_SA
#undef PG8_SB
#undef PG8_STAGE
#undef PG8_LDA
#undef PG8_LDB
#undef PG8_MMA
#undef PG8_WAIT_V
#undef PG8_WAIT_L
#undef PG8_BAR
#undef PG8_SCHED
}
}
#include <hip/hip_bf16.h>
#include <cmath>
namespace attn_body {
using bf16=__hip_bfloat16;
using bf16x8=__attribute__((ext_vector_type(8)))short;
using s16x4=__attribute__((ext_vector_type(4)))short;
using f32x16=__attribute__((ext_vector_type(16)))float;
using u32x4=__attribute__((ext_vector_type(4)))unsigned;
constexpr int BATCH=2,NHEAD=16,SEQ=16384,D=64,DM=NHEAD*D;
constexpr int NW=8,QBLK=32,QB=QBLK*NW,KVBLK=64,NQB=SEQ/QB;
constexpr int ATTN_PITCH=DM, ATTN_UNIT_ROWS=QB;
__device__ __forceinline__ int crow(int r,int hi){return (r&3)+8*(r>>2)+4*hi;}
#define SBAR() __builtin_amdgcn_sched_barrier(0)
__device__ __forceinline__ void cmask(f32x16&p0,f32x16&p1,int jb,int qrel,int hi){
  const float NEG=-INFINITY; int kb=64*jb+4*hi;
  #pragma unroll
  for(int r=0;r<16;++r){int kv=kb+(r&3)+8*(r>>2); if(kv>qrel)p0[r]=NEG; if(kv+32>qrel)p1[r]=NEG;}
}

constexpr int NSLOT=3, SLOTB=8192;
constexpr int LDS_K=0, LDS_V=NSLOT*SLOTB, LDS_WS=2*NSLOT*SLOTB, LDS_OST=LDS_WS+NW*64*4, LDS_BETA=LDS_OST+NW*4096, LDS_MISC=LDS_BETA+SEQ*4, LDS_BYTES=LDS_MISC+64;
constexpr float C2=0.125f*1.4426950408889634f;
__device__ __forceinline__ void glds16(const void*gsrc,unsigned lds_dst){unsigned keep;
  asm volatile("s_mov_b32 %0, m0\n\ts_mov_b32 m0, %2\n\ts_nop 0\n\tglobal_load_lds_dwordx4 %1, off\n\ts_mov_b32 m0, %0":"=&s"(keep):"v"(gsrc),"s"(lds_dst):"memory");}
__device__ __forceinline__ float max3f(float a,float b,float c){float r;asm("v_max3_f32 %0, %1, %2, %3":"=v"(r):"v"(a),"v"(b),"v"(c));return r;}
__device__ __forceinline__ float max2f(float a,float b){float r;asm("v_max_f32_e32 %0, %1, %2":"=v"(r):"v"(a),"v"(b));return r;}
__device__ __forceinline__ float fadd_s(float a,float b){float r;asm("v_add_f32_e32 %0, %1, %2":"=v"(r):"v"(a),"v"(b));return r;}
__device__ __forceinline__ float fsub_s(float a,float b){float r;asm("v_sub_f32_e32 %0, %1, %2":"=v"(r):"v"(a),"v"(b));return r;}
typedef float f32x4_t __attribute__((ext_vector_type(4))); typedef float f32x2_t __attribute__((ext_vector_type(2))); typedef __bf16 bf16x2_t __attribute__((ext_vector_type(2)));
__device__ __forceinline__ unsigned cvtpk_s(float lo,float hi){f32x2_t v={lo,hi};bf16x2_t b=__builtin_convertvector(v,bf16x2_t);return __builtin_bit_cast(unsigned,b);}
#define WAIT_BAR(N) asm volatile("s_waitcnt vmcnt(" #N ") lgkmcnt(0)\n\ts_barrier":::"memory")

__device__ __forceinline__ void qkt(f32x16&p0,f32x16&p1,const char*Kslot,const bf16x8*qr,const f32x16&negm,int r32,int hi){
  const char*kb=Kslot+hi*1024+r32*16;
  #pragma unroll
  for(int d0=0;d0<4;++d0){
    const bf16x8 b0=*reinterpret_cast<const bf16x8*>(kb+d0*2048);
    const bf16x8 b1=*reinterpret_cast<const bf16x8*>(kb+d0*2048+512);
    if(d0==0){p0=__builtin_amdgcn_mfma_f32_32x32x16_bf16(b0,qr[0],negm,0,0,0);p1=__builtin_amdgcn_mfma_f32_32x32x16_bf16(b1,qr[0],negm,0,0,0);}
    else{p0=__builtin_amdgcn_mfma_f32_32x32x16_bf16(b0,qr[d0],p0,0,0,0);p1=__builtin_amdgcn_mfma_f32_32x32x16_bf16(b1,qr[d0],p1,0,0,0);}}
}
typedef __attribute__((address_space(3))) const char* lds_cptr;
typedef short v4i16_t __attribute__((ext_vector_type(4)));
__device__ __forceinline__ void kload8(bf16x8*kf,lds_cptr kp){
  kf[0]=*(const __attribute__((address_space(3))) bf16x8*)(kp);      kf[1]=*(const __attribute__((address_space(3))) bf16x8*)(kp+512);
  kf[2]=*(const __attribute__((address_space(3))) bf16x8*)(kp+2048); kf[3]=*(const __attribute__((address_space(3))) bf16x8*)(kp+2560);
  kf[4]=*(const __attribute__((address_space(3))) bf16x8*)(kp+4096); kf[5]=*(const __attribute__((address_space(3))) bf16x8*)(kp+4608);
  kf[6]=*(const __attribute__((address_space(3))) bf16x8*)(kp+6144); kf[7]=*(const __attribute__((address_space(3))) bf16x8*)(kp+6656);
}
__device__ __forceinline__ void kload2(bf16x8*kf,lds_cptr kp,int j){ kf[2*j]=*(const __attribute__((address_space(3))) bf16x8*)(kp+j*2048); kf[2*j+1]=*(const __attribute__((address_space(3))) bf16x8*)(kp+j*2048+512); }
__device__ __forceinline__ s16x4 vtr(lds_cptr p){ return __builtin_bit_cast(s16x4,__builtin_amdgcn_ds_read_tr16_b64_v4i16((__attribute__((address_space(3))) v4i16_t*)p)); }
__device__ __forceinline__ float rowmax(const f32x16&p0,const f32x16&p1){
  float a=max3f(p0[0],p0[1],p1[0]),b=max3f(p0[2],p0[3],p1[1]);a=max3f(a,p1[2],p1[3]);
  #pragma unroll
  for(int r=4;r<16;r+=4){a=max3f(a,p0[r],p0[r+1]);b=max3f(b,p0[r+2],p0[r+3]);a=max3f(a,p1[r],p1[r+1]);b=max3f(b,p1[r+2],p1[r+3]);}
  const float m=max2f(a,b);
  auto rr=__builtin_amdgcn_permlane32_swap(__float_as_uint(m),__float_as_uint(m),false,false);
  return max2f(__uint_as_float(rr[0]),__uint_as_float(rr[1]));
}
__device__ __forceinline__ void pv(f32x16*o,int vb,bf16x8 pa0,bf16x8 pa1,bf16x8 pa2,bf16x8 pa3){
  #pragma unroll
  for(int d0=0;d0<2;++d0){s16x4 lo[4],hi[4];
    #pragma unroll
    for(int ks=0;ks<4;++ks){
      asm volatile("ds_read_b64_tr_b16 %0,%1 offset:%c2":"=&v"(lo[ks]):"v"(vb),"i"(d0*4096+ks*1024):"memory");
      asm volatile("ds_read_b64_tr_b16 %0,%1 offset:%c2":"=&v"(hi[ks]):"v"(vb),"i"(d0*4096+ks*1024+512):"memory");}
    asm volatile("s_waitcnt lgkmcnt(0)":::"memory");SBAR();
    #define PK(k) (bf16x8){lo[k][0],lo[k][1],lo[k][2],lo[k][3],hi[k][0],hi[k][1],hi[k][2],hi[k][3]}
    o[d0]=__builtin_amdgcn_mfma_f32_32x32x16_bf16(pa0,PK(0),o[d0],0,0,0);
    o[d0]=__builtin_amdgcn_mfma_f32_32x32x16_bf16(pa1,PK(1),o[d0],0,0,0);
    o[d0]=__builtin_amdgcn_mfma_f32_32x32x16_bf16(pa2,PK(2),o[d0],0,0,0);
    o[d0]=__builtin_amdgcn_mfma_f32_32x32x16_bf16(pa3,PK(3),o[d0],0,0,0);
    #undef PK
  }
}

#ifndef ATTN_STORE16
#define ATTN_STORE16(p,v) (*(u32x4*)(p)=(v))
#endif
template<int THRL> __device__ __forceinline__ void attn_unit(int b,int h,int qb,const bf16*Q,const bf16*__restrict__ K,const bf16*__restrict__ V,bf16*O,const bf16*__restrict__ Gt,const float*__restrict__ cs0,float kmax,char*shm){
  int tid=threadIdx.x; asm volatile("":"+v"(tid)); const int lane=tid&63,r32=lane&31,hi=lane>>5; const int wid=__builtin_amdgcn_readfirstlane(tid>>6);
  const long rowbase=(long)b*SEQ; const int q0=qb*QB;
  const bf16*Qw=Q+(rowbase+q0+wid*QBLK)*DM+h*D;
  bf16x8 qr[4];
  #pragma unroll
  for(int d0=0;d0<4;++d0)qr[d0]=*reinterpret_cast<const bf16x8*>(&Qw[(long)r32*DM+d0*16+hi*8]);
  int t0;
  { typedef __attribute__((address_space(3))) float* lds_fptr; typedef __attribute__((address_space(3))) int* lds_iptr;
    lds_fptr misc=(lds_fptr)((lds_cptr)shm+LDS_MISC);
    float nq=0.f;
    #pragma unroll
    for(int d0=0;d0<4;++d0){
      #pragma unroll
      for(int j=0;j<8;++j){const float f=__uint_as_float(((unsigned)(unsigned short)qr[d0][j])<<16); nq+=f*f;}}
    {auto rr=__builtin_amdgcn_permlane32_swap(__float_as_uint(nq),__float_as_uint(nq),false,false);nq=__uint_as_float(rr[0])+__uint_as_float(rr[1]);}
    nq=fmaxf(nq,__int_as_float(__builtin_amdgcn_ds_swizzle(__float_as_int(nq),(16<<10)|0x1f))); nq=fmaxf(nq,__int_as_float(__builtin_amdgcn_ds_swizzle(__float_as_int(nq),(8<<10)|0x1f)));
    nq=fmaxf(nq,__int_as_float(__builtin_amdgcn_ds_swizzle(__float_as_int(nq),(4<<10)|0x1f))); nq=fmaxf(nq,__int_as_float(__builtin_amdgcn_ds_swizzle(__float_as_int(nq),(2<<10)|0x1f)));
    nq=fmaxf(nq,__int_as_float(__builtin_amdgcn_ds_swizzle(__float_as_int(nq),(1<<10)|0x1f)));
    if(lane==0)misc[wid]=nq;
    if(tid==0)((lds_iptr)misc)[8]=0;
    asm volatile("s_waitcnt vmcnt(0) lgkmcnt(0)\n\ts_barrier":::"memory");
    float q2=misc[0];
    #pragma unroll
    for(int w_=1;w_<NW;++w_)q2=fmaxf(q2,misc[w_]);
    const float thr=-45.f-2.f*sqrtf(q2)*kmax*1.0001f;
    const int NT0=(q0+QB)/KVBLK; const float cref0=cs0[q0];
    if(tid>=1&&2*tid<=NT0-4){ const float bb=(cref0-cs0[128*tid-1])*1.4426950408889634f; if(bb<=thr)atomicMax((int*)((lds_iptr)misc+8),2*tid); }
    asm volatile("s_waitcnt vmcnt(0) lgkmcnt(0)\n\ts_barrier":::"memory");
    t0=__builtin_amdgcn_readfirstlane(((lds_iptr)misc)[8]);
  }
  const float*cs=cs0+t0*KVBLK;
  const bf16*Kh=K+(rowbase+(long)t0*KVBLK)*DM+h*D,*Vh=V+(rowbase+(long)t0*KVBLK)*DM+h*D;
  const unsigned lds0=(unsigned)(uintptr_t)shm;
  float*wsf=(float*)(shm+LDS_WS)+wid*64;
  const bf16*ksrc=Kh+(long)lane*DM+wid*8;
  const bf16*vsrc=Vh+(long)(16*(wid&3)+(lane>>2))*DM+(wid>>2)*32+(lane&3)*8;
  const unsigned kdst=lds0+LDS_K+wid*1024, vdst=lds0+LDS_V+wid*1024;
  #define DMA_K(t,slot) glds16(ksrc+(long)(t)*KVBLK*DM,(unsigned)__builtin_amdgcn_readfirstlane(kdst+(slot)))
  #define DMA_V(t,slot) glds16(vsrc+(long)(t)*KVBLK*DM,(unsigned)__builtin_amdgcn_readfirstlane(vdst+(slot)))
  const int vb0=(int)(lds0+LDS_V)+((lane>>4)&1)*32+(lane&3)*8+(4*hi+((lane&15)>>2))*64;
  const char*Kbase=shm+LDS_K; bf16x8 kf[8];
  const lds_cptr shm3=(lds_cptr)shm; const lds_cptr kp0=shm3+LDS_K+hi*1024+r32*16; const lds_cptr vp0=shm3+LDS_V+((lane>>4)&1)*32+(lane&3)*8+(4*hi+((lane&15)>>2))*64;
  const int NT=(q0+QB)/KVBLK-t0;
  {
    typedef __attribute__((address_space(3))) float* lds_fptr; lds_fptr bt=(lds_fptr)((lds_cptr)shm+LDS_BETA);
    const float cref=cs0[q0]; const int nkv=NT*KVBLK;
    for(int s_=tid;s_<nkv;s_+=NW*64) bt[s_]=(cref-cs[s_])*1.4426950408889634f;
  }
  const lds_cptr bp0=(lds_cptr)shm+LDS_BETA+hi*16;
  #define LDB(P0,P1,t) do{ const lds_cptr bq_=bp0+(t)*256; _Pragma("unroll") for(int g_=0;g_<4;++g_){ \
      const f32x4_t u0_=*(const __attribute__((address_space(3))) f32x4_t*)(bq_+g_*32), u1_=*(const __attribute__((address_space(3))) f32x4_t*)(bq_+128+g_*32); \
      P0[4*g_]=u0_[0];P0[4*g_+1]=u0_[1];P0[4*g_+2]=u0_[2];P0[4*g_+3]=u0_[3]; P1[4*g_]=u1_[0];P1[4*g_+1]=u1_[1];P1[4*g_+2]=u1_[2];P1[4*g_+3]=u1_[3]; } }while(0)
  DMA_K(0,0);DMA_V(0,0);DMA_K(1,SLOTB);
  float mhat=0.f,l_reg=0.f;f32x16 o[2];o[0]=f32x16{};o[1]=f32x16{};f32x16 zero16=f32x16{};
  const int qrel=wid*QBLK+r32;
  #define CMASK(P0,P1,t) do{int jb_=(t)-(NT-4); if(jb_>=0)cmask(P0,P1,jb_,qrel,hi);}while(0)
  bool resc=false;
  #define START(P0,P1) do{ const float rm=rowmax(P0,P1); resc=false; \
    { const float dl=rm; mhat=fadd_s(mhat,dl); \
      _Pragma("unroll") for(int r=0;r<16;++r){P0[r]=fsub_s(P0[r],dl);P1[r]=fsub_s(P1[r],dl);} } \
    _Pragma("unroll") for(int r=0;r<16;++r)P0[r]=__builtin_amdgcn_exp2f(P0[r]); }while(0)
  #define RESC() do{ if(resc){ asm volatile("s_waitcnt lgkmcnt(0)":::"memory"); \
      _Pragma("unroll") for(int d_=0;d_<2;++d_) _Pragma("unroll") for(int r=0;r<16;++r)o[d_][r]*=wsf[crow(r,hi)]; } }while(0)
  f32x16 pA0,pA1,pB0,pB1;
  int sl_prev=0,sl_cur=0,sl_next=SLOTB;
  #define ROT() do{sl_prev=sl_cur;sl_cur=sl_next;sl_next=(sl_next==(NSLOT-1)*SLOTB)?0:sl_next+SLOTB;}while(0)
  DMA_K(2,2*SLOTB);
  WAIT_BAR(3);
  qkt(pA0,pA1,Kbase,qr,zero16,r32,hi);asm volatile("s_nop 15\n\ts_nop 7":"+v"(pA0),"+v"(pA1));
  { LDB(pB0,pB1,0); _Pragma("unroll") for(int r=0;r<16;++r){pA0[r]+=pB0[r];pA1[r]+=pB1[r];} }
  CMASK(pA0,pA1,0);
  START(pA0,pA1);
  _Pragma("unroll") for(int r=0;r<16;++r)pA1[r]=__builtin_amdgcn_exp2f(pA1[r]);
  LDB(pB0,pB1,1);
  WAIT_BAR(0);
  DMA_K(3,0);DMA_V(1,SLOTB);
  ROT();
  kload8(kf,kp0+sl_cur);
  WAIT_BAR(2);
  s16x4 vlo[8],vhi[8]; u32x4 pw0,pw1,pw2,pw3;
  #define PKW(P,B) cvtpk_s(P[B],P[B+1])
  #define PAF(k) __builtin_bit_cast(bf16x8,pw##k)
  #define VFR(i) (bf16x8){vlo[i][0],vlo[i][1],vlo[i][2],vlo[i][3],vhi[i][0],vhi[i][1],vhi[i][2],vhi[i][3]}
  #define PIN(x) asm volatile("":"+v"(x))
  #define MX3(a,b,c) __builtin_fmaxf(__builtin_fmaxf((a),(b)),(c))
  #define GAPA(MF,A0,A1,A2,A3,W0,W1,PW) do{ MF; sacc+=A0; sacc+=A1; sacc+=A2; sacc+=A3; PIN(sacc); W0; W1; PIN(PW); SBAR(); }while(0)
  #define EX(v) __builtin_amdgcn_exp2f(v)
  #define GAPB(MF,X,B) do{ MF; X[B]=EX(X[B]); X[B+1]=EX(X[B+1]); X[B+2]=EX(X[B+2]); X[B+3]=EX(X[B+3]); PIN(X); SBAR(); }while(0)
  #define VRD(i) do{ vlo[i]=vtr(vp_+(((i)>>2)*4096+((i)&3)*1024)); vhi[i]=vtr(vp_+(((i)>>2)*4096+((i)&3)*1024+512)); }while(0)
  #define KRD(G,j) do{ if(G){ kload2(kf,kp0+sl_next,j); SBAR(); } }while(0)
  #define STEP(C0,C1,P0,P1,t,GK,GV,GL) do{ SBAR(); \
    const lds_cptr vp_=vp0+sl_prev; \
    _Pragma("unroll") for(int r=0;r<16;++r){C0[r]-=mhat;C1[r]-=mhat;} \
    VRD(0); SBAR(); float sacc=(P0[0]+P0[1]); \
    GAPA(C0=__builtin_amdgcn_mfma_f32_32x32x16_bf16(kf[0],qr[0],C0,0,0,0), P0[2],P0[3],P0[4],P0[5],     pw0[0]=PKW(P0,0), pw0[1]=PKW(P0,2), pw0); \
    VRD(4); SBAR(); GAPA(C1=__builtin_amdgcn_mfma_f32_32x32x16_bf16(kf[1],qr[0],C1,0,0,0), P0[6],P0[7],P0[8],P0[9],     pw0[2]=PKW(P0,4), pw0[3]=PKW(P0,6), pw0); \
    VRD(1); SBAR(); GAPA(C0=__builtin_amdgcn_mfma_f32_32x32x16_bf16(kf[2],qr[1],C0,0,0,0),   P0[10],P0[11],P0[12],P0[13], pw1[0]=PKW(P0,8), pw1[1]=PKW(P0,10), pw1); \
    VRD(5); SBAR(); GAPA(C1=__builtin_amdgcn_mfma_f32_32x32x16_bf16(kf[3],qr[1],C1,0,0,0),   P0[14],P0[15],P1[0],P1[1],   pw1[2]=PKW(P0,12),pw1[3]=PKW(P0,14), pw1); \
    VRD(2); SBAR(); GAPA(C0=__builtin_amdgcn_mfma_f32_32x32x16_bf16(kf[4],qr[2],C0,0,0,0),   P1[2],P1[3],P1[4],P1[5],     pw2[0]=PKW(P1,0), pw2[1]=PKW(P1,2), pw2); \
    VRD(6); SBAR(); GAPA(C1=__builtin_amdgcn_mfma_f32_32x32x16_bf16(kf[5],qr[2],C1,0,0,0),   P1[6],P1[7],P1[8],P1[9],     pw2[2]=PKW(P1,4), pw2[3]=PKW(P1,6), pw2); \
    VRD(3); SBAR(); GAPA(C0=__builtin_amdgcn_mfma_f32_32x32x16_bf16(kf[6],qr[3],C0,0,0,0),   P1[10],P1[11],P1[12],P1[13], pw3[0]=PKW(P1,8), pw3[1]=PKW(P1,10), pw3); \
    VRD(7); SBAR(); GAPA(C1=__builtin_amdgcn_mfma_f32_32x32x16_bf16(kf[7],qr[3],C1,0,0,0),   P1[14],P1[15],0.f,0.f,       pw3[2]=PKW(P1,12),pw3[3]=PKW(P1,14), pw3); \
    l_reg+=sacc; \
    if(GV){LDB(P0,P1,(t)+1);} \
    if(GK){DMA_K((t)+3,sl_cur);} if(GV){DMA_V((t)+1,sl_next);} \
    CMASK(C0,C1,t); \
    { float a=MX3(C0[0],C0[1],C1[0]),b=MX3(C0[2],C0[3],C1[1]); a=MX3(a,C1[2],C1[3]); \
      _Pragma("unroll") for(int r=4;r<16;r+=4){a=MX3(a,C0[r],C0[r+1]);b=MX3(b,C0[r+2],C0[r+3]);a=MX3(a,C1[r],C1[r+1]);b=MX3(b,C1[r+2],C1[r+3]);} \
      float rm=__builtin_fmaxf(a,b); { auto rr=__builtin_amdgcn_permlane32_swap(__float_as_uint(rm),__float_as_uint(rm),false,false); rm=__builtin_fmaxf(__uint_as_float(rr[0]),__uint_as_float(rr[1])); } \
      resc=false; \
      if(__builtin_expect(__any(rm>(float)THRL),0)){ const float dl=__builtin_fmaxf(rm,0.f); mhat+=dl; \
        _Pragma("unroll") for(int r=0;r<16;++r){C0[r]-=dl;C1[r]-=dl;} \
        const float f=__builtin_amdgcn_exp2f(-dl); l_reg*=f; if(hi==0)wsf[r32]=f; resc=true; } } \
    SBAR(); \
    GAPB(o[0]=__builtin_amdgcn_mfma_f32_32x32x16_bf16(PAF(0),VFR(0),o[0],0,0,0), C0,0); \
    GAPB(o[1]=__builtin_amdgcn_mfma_f32_32x32x16_bf16(PAF(0),VFR(4),o[1],0,0,0), C0,4); \
    KRD(GL,0); GAPB(o[0]=__builtin_amdgcn_mfma_f32_32x32x16_bf16(PAF(1),VFR(1),o[0],0,0,0), C0,8); \
    KRD(GL,1); GAPB(o[1]=__builtin_amdgcn_mfma_f32_32x32x16_bf16(PAF(1),VFR(5),o[1],0,0,0), C0,12); \
    KRD(GL,2); GAPB(o[0]=__builtin_amdgcn_mfma_f32_32x32x16_bf16(PAF(2),VFR(2),o[0],0,0,0), C1,0); \
    KRD(GL,3); GAPB(o[1]=__builtin_amdgcn_mfma_f32_32x32x16_bf16(PAF(2),VFR(6),o[1],0,0,0), C1,4); \
    GAPB(o[0]=__builtin_amdgcn_mfma_f32_32x32x16_bf16(PAF(3),VFR(3),o[0],0,0,0), C1,8); \
    GAPB(o[1]=__builtin_amdgcn_mfma_f32_32x32x16_bf16(PAF(3),VFR(7),o[1],0,0,0), C1,12); \
    }while(0)
  int t=1;
  #undef CMASK
  #define CMASK(P0,P1,t) do{}while(0)
  for(;t+5<NT;t+=2){
    STEP(pB0,pB1,pA0,pA1,t,true,true,true);     WAIT_BAR(2); RESC(); ROT();
    STEP(pA0,pA1,pB0,pB1,t+1,true,true,true);   WAIT_BAR(2); RESC(); ROT();
  }
  #undef CMASK
  #define CMASK(P0,P1,t) do{int jb_=(t)-(NT-4); if(jb_>=0)cmask(P0,P1,jb_,qrel,hi);}while(0)
  #define ENDW(tt) do{ if((tt)+3<NT){WAIT_BAR(2);} else if((tt)+2<NT){WAIT_BAR(1);} else {WAIT_BAR(0);} }while(0)
  for(;t+1<NT;t+=2){
    STEP(pB0,pB1,pA0,pA1,t,(t+3<NT),(t+1<NT),(t+1<NT));       ENDW(t);   RESC(); ROT();
    STEP(pA0,pA1,pB0,pB1,t+1,(t+4<NT),(t+2<NT),(t+2<NT));     ENDW(t+1); RESC(); ROT();
  }
  STEP(pB0,pB1,pA0,pA1,NT-1,false,false,false); RESC();
  { float sacc=pB0[0]+pB0[1]; _Pragma("unroll") for(int r=2;r<16;++r)sacc+=pB0[r]; _Pragma("unroll") for(int r=0;r<16;++r)sacc+=pB1[r]; l_reg+=sacc;
    pw0=(u32x4){PKW(pB0,0),PKW(pB0,2),PKW(pB0,4),PKW(pB0,6)};pw1=(u32x4){PKW(pB0,8),PKW(pB0,10),PKW(pB0,12),PKW(pB0,14)};pw2=(u32x4){PKW(pB1,0),PKW(pB1,2),PKW(pB1,4),PKW(pB1,6)};pw3=(u32x4){PKW(pB1,8),PKW(pB1,10),PKW(pB1,12),PKW(pB1,14)};
    SBAR(); pv(o,vb0+sl_cur,PAF(0),PAF(1),PAF(2),PAF(3)); }
  #undef PKW
  #undef PAF
  #undef VFR
  #undef PIN
  #undef MX3
  #undef GAPA
  #undef GAPB
  #undef EX
  #undef VRD
  #undef KRD
  #undef STEP
  #undef ENDW
  {auto rr=__builtin_amdgcn_permlane32_swap(__float_as_uint(l_reg),__float_as_uint(l_reg),false,false);l_reg=__uint_as_float(rr[0])+__uint_as_float(rr[1]);}
  if(hi==0)wsf[32+r32]=l_reg;asm volatile("s_waitcnt lgkmcnt(0)":::"memory");
  float rli[16];
  #pragma unroll
  for(int r=0;r<16;++r)rli[r]=__builtin_amdgcn_rcpf(wsf[32+crow(r,hi)]);
  bf16*Ow=O+(rowbase+q0+wid*QBLK)*DM+h*D;
  { bf16*stg=(bf16*)(shm+LDS_OST)+wid*2048;
    #pragma unroll
    for(int r=0;r<16;++r){const int orow=crow(r,hi);
      #pragma unroll
      for(int d0=0;d0<2;++d0)stg[orow*64+d0*32+r32]=__float2bfloat16(o[d0][r]*rli[r]);}
    asm volatile("s_waitcnt lgkmcnt(0)":::"memory");
    const bf16*Gw=Gt+(rowbase+q0+wid*QBLK)*DM+h*D;
    #pragma unroll
    for(int i=0;i<4;++i){const int row=i*8+(lane>>3),ch=lane&7; u32x4 v=*(const u32x4*)(stg+row*64+ch*8); const u32x4 gq=*(const u32x4*)(Gw+(long)row*DM+ch*8);
      #pragma unroll
      for(int e=0;e<4;++e){ const float o0=__uint_as_float(v[e]<<16),o1=__uint_as_float(v[e]&0xffff0000u),g0=__uint_as_float(gq[e]<<16),g1=__uint_as_float(gq[e]&0xffff0000u);
        const float s0=__builtin_amdgcn_rcpf(1.f+__builtin_amdgcn_exp2f(-1.4426950408889634f*g0)),s1=__builtin_amdgcn_rcpf(1.f+__builtin_amdgcn_exp2f(-1.4426950408889634f*g1));
        v[e]=cvtpk_s(o0*s0,o1*s1); }
      ATTN_STORE16(Ow+(long)row*DM+ch*8,v);} }
  asm volatile("s_waitcnt lgkmcnt(0)\n\ts_barrier":::"memory");
  #undef DMA_K
  #undef DMA_V
  #undef LDB
  #undef CMASK
  #undef START
  #undef RESC
  #undef ROT
}
constexpr int ATTN_LDS_BYTES=LDS_BYTES;
struct AttnTensors { const bf16* Q; const bf16* K; const bf16* V; bf16* O; const bf16* G; const float* C; float kmax; };
struct AttnUnit { int bh; int qb; };
struct StaticOrder {
  int vcu,G;
  __device__ __forceinline__ explicit StaticOrder(int grid,int block):vcu((grid%8==0)?(block%8)*(grid/8)+block/8:block),G(grid){}
  __device__ __forceinline__ bool next(int i,AttnUnit&u)const{
    if(G==256){ if(i>=8)return false; u.bh=(vcu+5*i)&31; const int s=vcu>>5; const int qi=i*8+((i&1)?7-s:s); u.qb=NQB-1-qi; return true; }
    const int L=i*G+vcu; if(L>=BATCH*NHEAD*NQB)return false; u.bh=L%(BATCH*NHEAD); u.qb=NQB-1-L/(BATCH*NHEAD); return true; }
  __device__ __forceinline__ void a_ready(const AttnUnit&)const{}
  __device__ __forceinline__ void done(const AttnUnit&)const{}
};
template<class Sched,int THRL=8> __device__ __forceinline__ void attn_phase(char*lds,const AttnTensors&T,const Sched&S){
  AttnUnit u;
  for(int i=0;S.next(i,u);++i){ S.a_ready(u); attn_unit<THRL>(u.bh/NHEAD,u.bh%NHEAD,u.qb,T.Q,T.K,T.V,T.O,T.G,T.C+(long)u.bh*SEQ,T.kmax,lds); S.done(u); }
}
#undef SBAR
#undef WAIT_BAR
}
#ifndef PG8_SP2
#define PG8_SP2 true
#endif
#ifndef PG8_ALIGN
#define PG8_ALIGN true
#endif
constexpr int NWAVES = 8;
constexpr int SEQL = 16384, NB = 2, M = NB * SEQL, D = 1024, FF = 2816, PLE = 256, DEPTH = 4;
constexpr int GLA_IN = 3088, GLA_INP = 3328, KVF_N = 2064, KVF_NP = 2304;
constexpr int NCH = SEQL / 64;
constexpr float LN_EPS = 1e-5f;
constexpr float DN_ALPHA = 1.681792830507429f;
constexpr size_t MiB = 1u << 20;
constexpr size_t WS_W = 1 * MiB, WS_XB = 50 * MiB, WS_AR = 114 * MiB, WS_END = (114 + 476) * MiB;
constexpr size_t OW_F1IN = 0, OW_F1OUT = 5767168, OW_F2IN = 8650752, OW_F2OUT = 14417920, OW_PG = 17301504, OW_PP = 18350080, OW_MIXIN = 18612224, OW_MIXO = 22020096, OW_KVF = 23068672;
constexpr size_t AR_H = 0, AR_PB = 176 * MiB, AR_PLE = 280 * MiB, AR_KSH = 344 * MiB, AR_VSH = 408 * MiB, AR_CSH = 472 * MiB, AR_FLOG = 474 * MiB;
constexpr size_t AR_GQ = 0, AR_GK = 32 * MiB, AR_GV = 64 * MiB, AR_GR = 128 * MiB, AR_GA = 192 * MiB, AR_GD = 194 * MiB, AR_GKT = 196 * MiB, AR_GVT = 228 * MiB, AR_GST = 292 * MiB;
constexpr size_t AR_FQ = 0, AR_FG = 64 * MiB, AR_FO = 128 * MiB;
constexpr int LDS_BYTES = 150016;
static_assert(attn_body::ATTN_LDS_BYTES <= LDS_BYTES && pg8::STAGE_BYTES <= LDS_BYTES, "LDS map");

#define LAS __attribute__((address_space(3)))
typedef unsigned short bf16;
typedef unsigned v4u __attribute__((ext_vector_type(4)));
typedef unsigned v2u __attribute__((ext_vector_type(2)));
typedef float f32x4 __attribute__((ext_vector_type(4)));
typedef float f32x16 __attribute__((ext_vector_type(16)));
typedef short bf16x8 __attribute__((ext_vector_type(8)));
typedef short bf16x4 __attribute__((ext_vector_type(4)));
#define LDS_WAIT() asm volatile("s_waitcnt lgkmcnt(0)" ::: "memory")
__device__ __forceinline__ unsigned pk2(float lo, float hi) { typedef float f2 __attribute__((ext_vector_type(2))); typedef __bf16 b2 __attribute__((ext_vector_type(2))); f2 v = {lo, hi}; b2 b = __builtin_convertvector(v, b2); return __builtin_bit_cast(unsigned, b); }
__device__ __forceinline__ float bflo(unsigned w) { return __uint_as_float(w << 16); }
__device__ __forceinline__ float bfhi(unsigned w) { return __uint_as_float(w & 0xffff0000u); }
template <int O> __device__ __forceinline__ float swz_xor(float v) { return __int_as_float(__builtin_amdgcn_ds_swizzle(__float_as_int(v), (O << 10) | 0x1f)); }
__device__ __forceinline__ float half_sum(float v) { auto rr = __builtin_amdgcn_permlane32_swap(__float_as_uint(v), __float_as_uint(v), false, false); return __uint_as_float(rr[0]) + __uint_as_float(rr[1]); }
__device__ __forceinline__ float half_max(float v) { auto rr = __builtin_amdgcn_permlane32_swap(__float_as_uint(v), __float_as_uint(v), false, false); return fmaxf(__uint_as_float(rr[0]), __uint_as_float(rr[1])); }
__device__ __forceinline__ float wave_sum(float v) { v += swz_xor<1>(v); v += swz_xor<2>(v); v += swz_xor<4>(v); v += swz_xor<8>(v); v += swz_xor<16>(v); return half_sum(v); }
__device__ __forceinline__ float wave_max(float v) { v = fmaxf(v, swz_xor<1>(v)); v = fmaxf(v, swz_xor<2>(v)); v = fmaxf(v, swz_xor<4>(v)); v = fmaxf(v, swz_xor<8>(v)); v = fmaxf(v, swz_xor<16>(v)); return half_max(v); }

#define XB_TMO      128
#define XB_XCNT(j)  (256  + 64 * (j))
#define XB_XSUB(j)  (1280 + 64 * (j))
#define XB_XGEN(j)  (2304 + 64 * (j))
#define XB_TOP      3328
#define XB_TOPGEN   3392
#define XCD_BAR_WORDS 3456
#define XB_SPIN_CAP (1u << 18)

__device__ __forceinline__ unsigned xb_ld(unsigned* p)              { return __hip_atomic_load(p, __ATOMIC_RELAXED, __HIP_MEMORY_SCOPE_AGENT); }
__device__ __forceinline__ unsigned xb_add(unsigned* p, unsigned v) { return __hip_atomic_fetch_add(p, v, __ATOMIC_RELAXED, __HIP_MEMORY_SCOPE_AGENT); }
__device__ __forceinline__ unsigned xb_xcc_id() { return (unsigned)__builtin_amdgcn_s_getreg((3 << 11) | 20) & 0xFu; }
#define XB_SPIN(cond, bar) do { unsigned _sp = 0; while (cond) { __builtin_amdgcn_s_sleep(1); \
    if ((++_sp & 255u) == 0u) { if (xb_ld(&(bar)[XB_TMO])) break; if (_sp > XB_SPIN_CAP) { atomicAdd(&(bar)[XB_TMO], 1u); break; } } } } while (0)

struct XcdBarrier {
    unsigned* bar; unsigned x;
    volatile LAS unsigned* st;
};

__device__ __forceinline__ XcdBarrier xcd_barrier_post(unsigned* bar, volatile LAS unsigned* st) {
    XcdBarrier b; b.bar = bar; b.x = xb_xcc_id(); b.st = st;
    if (threadIdx.x == 0) (void)xb_add(&bar[XB_XCNT(b.x)], 1u);
    return b;
}
__device__ __forceinline__ void xcd_barrier_complete(unsigned* bar, unsigned x, unsigned& nloc, unsigned& nx) {
    const unsigned G = gridDim.x * gridDim.y * gridDim.z;
    unsigned sum, cnt, mine, sp = 0u;
    for (;;) {
        sum = 0u; cnt = 0u; mine = 0u;
#pragma unroll
        for (unsigned j = 0; j < 16; ++j) { const unsigned c = xb_ld(&bar[XB_XCNT(j)]); sum += c; cnt += (c > 0u) ? 1u : 0u; mine = (j == x) ? c : mine; }
        if (sum == G) break;
        __builtin_amdgcn_s_sleep(1);
        if ((++sp & 255u) == 0u) { if (xb_ld(&bar[XB_TMO])) break; if (sp > XB_SPIN_CAP) { atomicAdd(&bar[XB_TMO], 1u); break; } }
    }
    nloc = mine > 0u ? mine : 1u; nx = cnt > 0u ? cnt : 1u;
}

__device__ __forceinline__ void xcd_barrier(const XcdBarrier& b) {
    asm volatile("s_waitcnt vmcnt(0)" ::: "memory");
    __syncthreads();
    if (threadIdx.x == 0) {
        unsigned* bar = b.bar;
        __builtin_amdgcn_s_waitcnt(0);
        unsigned nloc = b.st[0], nx = b.st[1];
        if (nloc == 0u) { xcd_barrier_complete(bar, b.x, nloc, nx); b.st[0] = nloc; b.st[1] = nx; }
        const unsigned old = xb_add(&bar[XB_XSUB(b.x)], 1u);
        const unsigned gen = old / nloc;
        if (old + 1u == (gen + 1u) * nloc) {
            __builtin_amdgcn_fence(__ATOMIC_RELEASE, "agent");
            asm volatile("s_waitcnt vmcnt(0)" ::: "memory");
            const unsigned og = xb_add(&bar[XB_TOP], 1u);
            const unsigned tg = og / nx;
            if (og + 1u == (tg + 1u) * nx) xb_add(&bar[XB_TOPGEN], 1u);
            else XB_SPIN(xb_ld(&bar[XB_TOPGEN]) == tg, bar);
            __builtin_amdgcn_fence(__ATOMIC_ACQUIRE, "agent");
            xb_add(&bar[XB_XGEN(b.x)], 1u);
            asm volatile("s_waitcnt vmcnt(0)" ::: "memory");
        } else {
            XB_SPIN(xb_ld(&bar[XB_XGEN(b.x)]) == gen, bar);
            __builtin_amdgcn_fence(__ATOMIC_ACQUIRE, "agent");
            asm volatile("s_waitcnt vmcnt(0)" ::: "memory");
        }
    }
    __syncthreads();
}

struct Args { const float* in[24]; float* out; unsigned char* ws; };

struct Frame {
    unsigned char* lds; unsigned char* ws; unsigned char* ar;
    int tid, lane, wave, G, gw, NGW, bx;
};

__device__ __forceinline__ void tr_item(const float* __restrict__ W, int K, int N, int nblk, bf16* __restrict__ WT, int mode, float* scr, int item, int lane) {
    const int kb = item / nblk, nb = item % nblk, k0 = 64 * kb, n0 = 32 * nb;
    const int nn = n0 + (lane & 31); const bool ok = nn < N;
#pragma unroll 8
    for (int i = 0; i < 32; ++i) { const int kk = 2 * i + (lane >> 5); scr[kk * 33 + (lane & 31)] = ok ? W[(size_t)(k0 + kk) * N + nn] : 0.f; }
    LDS_WAIT();
    const int c = lane & 7;
#pragma unroll
    for (int j = 0; j < 4; ++j) { const int n = (lane >> 3) + 8 * j; const float* s = scr + (8 * c) * 33 + n;
        v4u o; o.x = pk2(s[0 * 33], s[1 * 33]); o.y = pk2(s[2 * 33], s[3 * 33]); o.z = pk2(s[4 * 33], s[5 * 33]); o.w = pk2(s[6 * 33], s[7 * 33]);
        const int gn = n0 + n; int drow = gn;
        if (mode) drow = (gn < FF) ? (gn / 128) * 256 + (gn % 128) : ((gn - FF) / 128) * 256 + 128 + ((gn - FF) % 128);
        *(v4u*)(WT + (size_t)drow * K + k0 + 8 * c) = o; }
    LDS_WAIT();
}
__device__ __forceinline__ void convert_weights(const Frame& F, const float* w_f1in, const float* w_f2in, const float* w_f1out, const float* w_f2out, const float* w_pg, const float* w_pp, const float* w_glain, const float* w_foxin, const float* w_glao, const float* w_foxo, const float* w_kvf, int L, bool with_kvf) {
    float* scr = (float*)(F.lds + F.wave * 16384);
    bf16* Wb = (bf16*)(F.ws + WS_W);
    const int I0 = 16 * 176, I1 = 44 * 32, I4 = 16 * 32, I5 = 4 * 32, I6 = (L < 2) ? 16 * (GLA_INP / 32) : 16 * 64, I7 = 16 * 32, I8 = with_kvf ? 16 * (KVF_NP / 32) : 0;
    const int NIT = 2 * I0 + 2 * I1 + I4 + I5 + I6 + I7 + I8;
    for (int it = F.gw; it < NIT; it += F.NGW) {
        int r = it;
        if (r < I0) { tr_item(w_f1in + (size_t)L * D * 2 * FF, D, 2 * FF, 176, Wb + OW_F1IN, 1, scr, r, F.lane); continue; } r -= I0;
        if (r < I0) { tr_item(w_f2in + (size_t)L * D * 2 * FF, D, 2 * FF, 176, Wb + OW_F2IN, 1, scr, r, F.lane); continue; } r -= I0;
        if (r < I1) { tr_item(w_f1out + (size_t)L * FF * D, FF, D, 32, Wb + OW_F1OUT, 0, scr, r, F.lane); continue; } r -= I1;
        if (r < I1) { tr_item(w_f2out + (size_t)L * FF * D, FF, D, 32, Wb + OW_F2OUT, 0, scr, r, F.lane); continue; } r -= I1;
        if (r < I4) { tr_item(w_pg + (size_t)L * D * D, D, D, 32, Wb + OW_PG, 0, scr, r, F.lane); continue; } r -= I4;
        if (r < I5) { tr_item(w_pp + (size_t)L * PLE * D, PLE, D, 32, Wb + OW_PP, 0, scr, r, F.lane); continue; } r -= I5;
        if (r < I6) { if (L < 2) tr_item(w_glain + (size_t)L * D * GLA_IN, D, GLA_IN, GLA_INP / 32, Wb + OW_MIXIN, 0, scr, r, F.lane);
                      else tr_item(w_foxin + (size_t)(L - 2) * D * 2048, D, 2048, 64, Wb + OW_MIXIN, 0, scr, r, F.lane); continue; } r -= I6;
        if (r < I7) { tr_item((L < 2) ? w_glao + (size_t)L * D * D : w_foxo + (size_t)(L - 2) * D * D, D, D, 32, Wb + OW_MIXO, 0, scr, r, F.lane); continue; } r -= I7;
        tr_item(w_kvf, D, KVF_N, KVF_NP / 32, Wb + OW_KVF, 0, scr, r, F.lane);
    }
}
__device__ __forceinline__ void cvt_rows(const Frame& F, const float* __restrict__ src, bf16* __restrict__ dst, size_t n) {
    const size_t nthr = (size_t)F.G * 512, t0 = (size_t)F.bx * 512 + F.tid;
    for (size_t i = t0 * 8; i < n; i += nthr * 8) {
        const f32x4 a = *(const f32x4*)(src + i), b = *(const f32x4*)(src + i + 4);
        v4u o; o.x = pk2(a[0], a[1]); o.y = pk2(a[2], a[3]); o.z = pk2(b[0], b[1]); o.w = pk2(b[2], b[3]);
        *(v4u*)(dst + i) = o;
    }
}
__device__ __forceinline__ void ln_phase(const Frame& F, const float* __restrict__ g, const float* __restrict__ bta, float* X, bf16* XB, float* ST, bool write_x) {
    f32x4 gv[4], bv[4];
#pragma unroll
    for (int j = 0; j < 4; ++j) { gv[j] = ((const f32x4*)g)[F.lane + 64 * j]; bv[j] = ((const f32x4*)bta)[F.lane + 64 * j]; }
    f32x4 v[4], vn[4];
    int m = F.gw;
    if (m < M) {
#pragma unroll
        for (int j = 0; j < 4; ++j) v[j] = ((const f32x4*)(X + (size_t)m * D) + F.lane)[64 * j];
    }
    for (; m < M; m += F.NGW) {
        const int mn = m + F.NGW;
        if (mn < M) {
#pragma unroll
            for (int j = 0; j < 4; ++j) vn[j] = ((const f32x4*)(X + (size_t)mn * D) + F.lane)[64 * j];
        }
        float s = 0.f;
#pragma unroll
        for (int j = 0; j < 4; ++j) s += (v[j][0] + v[j][1]) + (v[j][2] + v[j][3]);
        const float mean = wave_sum(s) * (1.f / D); float s2 = 0.f;
#pragma unroll
        for (int j = 0; j < 4; ++j) { v[j] = v[j] - mean; s2 += (v[j][0] * v[j][0] + v[j][1] * v[j][1]) + (v[j][2] * v[j][2] + v[j][3] * v[j][3]); }
        const float rstd = 1.f / sqrtf(wave_sum(s2) * (1.f / D) + LN_EPS);
        if (F.lane == 0) { ST[2 * m] = mean; ST[2 * m + 1] = rstd; }
        f32x4* xr = (f32x4*)(X + (size_t)m * D) + F.lane;
        v2u* o8 = (v2u*)(XB + (size_t)m * D) + F.lane;
#pragma unroll
        for (int j = 0; j < 4; ++j) { const f32x4 y = v[j] * rstd * gv[j] + bv[j]; if (write_x) xr[64 * j] = y; else { v2u w; w.x = pk2(y[0], y[1]); w.y = pk2(y[2], y[3]); o8[64 * j] = w; } }
#pragma unroll
        for (int j = 0; j < 4; ++j) v[j] = vn[j];
    }
}
__device__ __forceinline__ void cumsum_phase(const Frame& F, const float* __restrict__ flog, float* __restrict__ cs) {
    float* sh = (float*)F.lds;
    for (int u = F.bx; u < NB * 16; u += F.G) {
        const int b = u >> 4, h = u & 15; const float* src = flog + ((size_t)b * SEQL + (size_t)F.tid * 32) * 16 + h;
        float tot = 0.f;
#pragma unroll 8
        for (int i = 0; i < 32; ++i) tot += src[i * 16];
        __syncthreads();
        sh[F.tid] = tot;
        __syncthreads();
        float pre = 0.f;
        for (int i = 0; i < F.tid; ++i) pre += sh[i];
        float* dst = cs + (size_t)u * SEQL + F.tid * 32;
#pragma unroll 8
        for (int i = 0; i < 32; ++i) { pre += src[i * 16]; dst[i] = pre; }
    }
}
__device__ __forceinline__ void kmax_phase(const Frame& F, const bf16* __restrict__ KS, unsigned* cell) {
    float mx = 0.f;
    for (int m = F.gw; m < M; m += F.NGW) {
        const v4u a = *(const v4u*)(KS + (size_t)m * D + F.lane * 16), b = *(const v4u*)(KS + (size_t)m * D + F.lane * 16 + 8);
        float ss = 0.f;
#pragma unroll
        for (int e = 0; e < 4; ++e) { const float x0 = bflo(a[e]), x1 = bfhi(a[e]), y0 = bflo(b[e]), y1 = bfhi(b[e]); ss += x0 * x0 + x1 * x1 + y0 * y0 + y1 * y1; }
        ss += swz_xor<1>(ss); ss += swz_xor<2>(ss);
        mx = fmaxf(mx, ss);
    }
    mx = wave_max(mx);
    if (F.lane == 0) atomicMax(cell, __float_as_uint(mx));
}
__device__ __forceinline__ unsigned f2bf1(float x) { return pk2(x, 0.f) & 0xffffu; }
#define MFMA32(a, b, c) __builtin_amdgcn_mfma_f32_32x32x16_bf16((a), (b), (c), 0, 0, 0)
#define MFMA16(a, b, c) __builtin_amdgcn_mfma_f32_16x16x32_bf16((a), (b), (c), 0, 0, 0)
__device__ __forceinline__ void gla_prep(const Frame& F, const float* __restrict__ wa2, const float* __restrict__ ba) {
    bf16* GQ = (bf16*)(F.ar + AR_GQ); bf16* GK = (bf16*)(F.ar + AR_GK); const bf16* GV = (const bf16*)(F.ar + AR_GV); const float* GA = (const float*)(F.ar + AR_GA);
    float* GD = (float*)(F.ar + AR_GD); bf16* GKT = (bf16*)(F.ar + AR_GKT); bf16* GVT = (bf16*)(F.ar + AR_GVT);
    float* sa = (float*)F.lds; bf16* sv = (bf16*)(F.lds + 4096);
    const int j = F.tid;
    float w[16];
#pragma unroll
    for (int m = 0; m < 16; ++m) w[m] = wa2[m * 512 + j];
    const float bj = ba[j];
    for (int cu = F.bx; cu < NB * NCH; cu += F.G) {
        const size_t m0 = (size_t)cu * 64;
        __syncthreads();
        if (F.tid < 256) ((f32x4*)sa)[F.tid] = ((const f32x4*)(GA + m0 * 16))[F.tid];
        __syncthreads();
        float cum = 0.f; unsigned kt[32];
#pragma unroll
        for (int r = 0; r < 64; ++r) {
            const f32x4 a0 = ((const f32x4*)sa)[r * 4], a1 = ((const f32x4*)sa)[r * 4 + 1], a2 = ((const f32x4*)sa)[r * 4 + 2], a3 = ((const f32x4*)sa)[r * 4 + 3];
            float z = bj;
            z += a0[0] * w[0] + a0[1] * w[1] + a0[2] * w[2] + a0[3] * w[3];
            z += a1[0] * w[4] + a1[1] * w[5] + a1[2] * w[6] + a1[3] * w[7];
            z += a2[0] * w[8] + a2[1] * w[9] + a2[2] * w[10] + a2[3] * w[11];
            z += a3[0] * w[12] + a3[1] * w[13] + a3[2] * w[14] + a3[3] * w[15];
            cum += pg8::flogsig(z) * 0.0625f;
            const float e = __expf(cum), ei = __expf(-cum);
            const size_t o = (m0 + r) * 512 + j;
            GQ[o] = (bf16)f2bf1(bflo((unsigned)GQ[o]) * e);
            const unsigned kb = f2bf1(bflo((unsigned)GK[o]) * ei);
            GK[o] = (bf16)kb;
            if (r & 1) kt[r >> 1] |= kb << 16; else kt[r >> 1] = kb;
        }
        GD[(size_t)cu * 512 + j] = __expf(cum);
        v4u* kd = (v4u*)(GKT + ((size_t)cu * 512 + j) * 64);
#pragma unroll
        for (int i = 0; i < 8; ++i) { v4u t; t.x = kt[4 * i]; t.y = kt[4 * i + 1]; t.z = kt[4 * i + 2]; t.w = kt[4 * i + 3]; kd[i] = t; }
        for (int h = 0; h < 4; ++h) {
            __syncthreads();
#pragma unroll
            for (int i = 0; i < 4; ++i) { const int q = F.tid + 512 * i, row = q >> 5, cc = q & 31;
                *(v4u*)(sv + row * 264 + cc * 8) = *(const v4u*)(GV + (m0 + row) * 1024 + h * 256 + cc * 8); }
            __syncthreads();
            const int c = F.tid & 255, half = F.tid >> 8;
            unsigned vt[16];
#pragma unroll
            for (int s = 0; s < 16; ++s) vt[s] = (unsigned)sv[(half * 32 + 2 * s) * 264 + c] | ((unsigned)sv[(half * 32 + 2 * s + 1) * 264 + c] << 16);
            v4u* vd = (v4u*)(GVT + ((size_t)cu * 1024 + h * 256 + c) * 64 + half * 32);
#pragma unroll
            for (int i = 0; i < 4; ++i) { v4u t; t.x = vt[4 * i]; t.y = vt[4 * i + 1]; t.z = vt[4 * i + 2]; t.w = vt[4 * i + 3]; vd[i] = t; }
        }
    }
}
__device__ __forceinline__ void gla_scan(const Frame& F) {
    const bf16* GKT = (const bf16*)(F.ar + AR_GKT); const bf16* GVT = (const bf16*)(F.ar + AR_GVT); const float* GD = (const float*)(F.ar + AR_GD); bf16* GST = (bf16*)(F.ar + AR_GST);
    if (F.wave < 4) {
        const int l15 = F.lane & 15, l4 = F.lane >> 4;
        for (int wt = F.bx * 4 + F.wave; wt < 1024; wt += F.G * 4) {
            const int bh = wt >> 7, ib = (wt >> 4) & 7, cb = wt & 15, b = bh >> 2, h = bh & 3;
            const bf16* kp = GKT + ((size_t)b * NCH * 512 + h * 128 + ib * 16 + l15) * 64 + 8 * l4;
            const bf16* vp = GVT + ((size_t)b * NCH * 1024 + h * 256 + cb * 16 + l15) * 64 + 8 * l4;
            const float* dp = GD + (size_t)b * NCH * 512 + h * 128 + ib * 16 + 4 * l4;
            bf16* sp = GST + ((size_t)bh * NCH * 256 + cb * 16 + l15) * 128 + ib * 16 + 4 * l4;
            f32x4 S = {0.f, 0.f, 0.f, 0.f};
            bf16x8 ka[8][2], vb[8][2]; f32x4 dd[8];
#define SC_LOAD(u, n) do { ka[u][0] = *(const bf16x8*)(kp + (size_t)(n) * 32768); ka[u][1] = *(const bf16x8*)(kp + (size_t)(n) * 32768 + 32); \
                           vb[u][0] = *(const bf16x8*)(vp + (size_t)(n) * 65536); vb[u][1] = *(const bf16x8*)(vp + (size_t)(n) * 65536 + 32); \
                           dd[u] = *(const f32x4*)(dp + (size_t)(n) * 512); } while (0)
#pragma unroll
            for (int u = 0; u < 8; ++u) SC_LOAD(u, u);
            for (int n0 = 0; n0 < NCH; n0 += 8) {
#pragma unroll
                for (int u = 0; u < 8; ++u) {
                    const int n = n0 + u;
                    v2u st; st.x = pk2(S[0], S[1]); st.y = pk2(S[2], S[3]);
                    *(v2u*)(sp + (size_t)n * 32768) = st;
                    S = MFMA16(ka[u][0], vb[u][0], S); S = MFMA16(ka[u][1], vb[u][1], S);
                    S = S * dd[u];
                    if (n + 8 < NCH) SC_LOAD(u, n + 8);
                }
            }
#undef SC_LOAD
        }
    }
}
__device__ __forceinline__ void gla_out(const Frame& F, const float* __restrict__ gng, const float* __restrict__ gnb) {
    const bf16* GQ = (const bf16*)(F.ar + AR_GQ); const bf16* GK = (const bf16*)(F.ar + AR_GK); const bf16* GVT = (const bf16*)(F.ar + AR_GVT);
    const bf16* GST = (const bf16*)(F.ar + AR_GST); const bf16* GR = (const bf16*)(F.ar + AR_GR); bf16* OG = (bf16*)(F.ar + AR_GV);
    float* red = (float*)F.lds;
    const int lane = F.lane, r32 = lane & 31, hi = lane >> 5, w = F.wave;
    int par = 0;
    for (int uid = F.bx; uid < NB * NCH * 4; uid += F.G, par ^= 1) {
        const int cu = uid >> 2, h = uid & 3; const size_t m0 = (size_t)cu * 64;
        const int bh = (cu / NCH) * 4 + h, n = cu % NCH;
        f32x16 X00 = {}, X01 = {}, X11 = {};
        const bf16* qb = GQ + (m0 + r32) * 512 + h * 128 + 8 * hi;
        const bf16* kb = GK + (m0 + r32) * 512 + h * 128 + 8 * hi;
#pragma unroll
        for (int ks = 0; ks < 8; ++ks) {
            const bf16x8 q0 = *(const bf16x8*)(qb + ks * 16), q1 = *(const bf16x8*)(qb + 32 * 512 + ks * 16);
            const bf16x8 k0 = *(const bf16x8*)(kb + ks * 16), k1 = *(const bf16x8*)(kb + 32 * 512 + ks * 16);
            X00 = MFMA32(k0, q0, X00); X01 = MFMA32(k0, q1, X01); X11 = MFMA32(k1, q1, X11);
        }
#pragma unroll
        for (int reg = 0; reg < 16; ++reg) { const int sp = (reg & 3) + 8 * (reg >> 2) + 4 * hi; if (sp > r32) { X00[reg] = 0.f; X11[reg] = 0.f; } }
        bf16x8 B00[2], B01[2], B11[2];
#pragma unroll
        for (int sk = 0; sk < 2; ++sk) {
            v4u t;
            t.x = pk2(X00[8 * sk], X00[8 * sk + 1]); t.y = pk2(X00[8 * sk + 2], X00[8 * sk + 3]); t.z = pk2(X00[8 * sk + 4], X00[8 * sk + 5]); t.w = pk2(X00[8 * sk + 6], X00[8 * sk + 7]); B00[sk] = __builtin_bit_cast(bf16x8, t);
            t.x = pk2(X01[8 * sk], X01[8 * sk + 1]); t.y = pk2(X01[8 * sk + 2], X01[8 * sk + 3]); t.z = pk2(X01[8 * sk + 4], X01[8 * sk + 5]); t.w = pk2(X01[8 * sk + 6], X01[8 * sk + 7]); B01[sk] = __builtin_bit_cast(bf16x8, t);
            t.x = pk2(X11[8 * sk], X11[8 * sk + 1]); t.y = pk2(X11[8 * sk + 2], X11[8 * sk + 3]); t.z = pk2(X11[8 * sk + 4], X11[8 * sk + 5]); t.w = pk2(X11[8 * sk + 6], X11[8 * sk + 7]); B11[sk] = __builtin_bit_cast(bf16x8, t);
        }
        f32x16 o0 = {}, o1 = {};
        const bf16* vtp = GVT + ((size_t)cu * 1024 + h * 256 + 32 * w + r32) * 64 + 4 * hi;
#pragma unroll
        for (int stp = 0; stp < 2; ++stp)
#pragma unroll
            for (int sk = 0; sk < 2; ++sk) {
                const v2u lo = *(const v2u*)(vtp + 32 * stp + 16 * sk), hh = *(const v2u*)(vtp + 32 * stp + 16 * sk + 8);
                v4u t; t.x = lo.x; t.y = lo.y; t.z = hh.x; t.w = hh.y; const bf16x8 Av = __builtin_bit_cast(bf16x8, t);
                if (stp == 0) { o0 = MFMA32(Av, B00[sk], o0); o1 = MFMA32(Av, B01[sk], o1); } else { o1 = MFMA32(Av, B11[sk], o1); }
            }
        const bf16* stq = GST + (((size_t)bh * NCH + n) * 256 + 32 * w + r32) * 128 + 8 * hi;
#pragma unroll
        for (int ks = 0; ks < 8; ++ks) {
            const bf16x8 As = *(const bf16x8*)(stq + ks * 16);
            const bf16x8 q0 = *(const bf16x8*)(qb + ks * 16), q1 = *(const bf16x8*)(qb + 32 * 512 + ks * 16);
            o0 = MFMA32(As, q0, o0); o1 = MFMA32(As, q1, o1);
        }
        float s0 = 0.f, q0s = 0.f, s1 = 0.f, q1s = 0.f;
#pragma unroll
        for (int reg = 0; reg < 16; ++reg) { s0 += o0[reg]; q0s += o0[reg] * o0[reg]; s1 += o1[reg]; q1s += o1[reg] * o1[reg]; }
        s0 = half_sum(s0); q0s = half_sum(q0s); s1 = half_sum(s1); q1s = half_sum(q1s);
        if (hi == 0) { float* rp = red + ((par * 8 + w) * 64 + r32) * 2; rp[0] = s0; rp[1] = q0s; rp[64] = s1; rp[65] = q1s; }
        __syncthreads();
        float mean[2], rstd[2];
#pragma unroll
        for (int st = 0; st < 2; ++st) { float ts = 0.f, tq = 0.f;
#pragma unroll
            for (int ww = 0; ww < 8; ++ww) { const float* rp = red + ((par * 8 + ww) * 64 + 32 * st + r32) * 2; ts += rp[0]; tq += rp[1]; }
            mean[st] = ts * (1.f / 256.f); const float var = fmaxf(tq * (1.f / 256.f) - mean[st] * mean[st], 0.f); rstd[st] = 1.f / sqrtf(var + LN_EPS); }
#pragma unroll
        for (int st = 0; st < 2; ++st) {
            const size_t row = m0 + 32 * st + r32;
#pragma unroll
            for (int g = 0; g < 4; ++g) {
                const int gl = h * 256 + 32 * w + 8 * g + 4 * hi;
                const f32x4 gg = *(const f32x4*)(gng + gl), bb = *(const f32x4*)(gnb + gl);
                const v2u rr = *(const v2u*)(GR + row * 1024 + gl);
                const float rv[4] = {bflo(rr.x), bfhi(rr.x), bflo(rr.y), bfhi(rr.y)};
                float y[4];
#pragma unroll
                for (int jj = 0; jj < 4; ++jj) { const float ov = (st == 0) ? o0[4 * g + jj] : o1[4 * g + jj];
                    y[jj] = ((ov - mean[st]) * rstd[st] * gg[jj] + bb[jj]) * (rv[jj] * pg8::fsigmoid(rv[jj])); }
                v2u ow; ow.x = pk2(y[0], y[1]); ow.y = pk2(y[2], y[3]);
                *(v2u*)(OG + row * 1024 + gl) = ow;
            }
        }
    }
}
__global__ void __launch_bounds__(NWAVES * 64, 2) yoco_fwd(Args a) {
    extern __shared__ __attribute__((aligned(16))) unsigned char lds_raw[];
    cg::grid_group grid = cg::this_grid();
    Frame F;
    F.lds = lds_raw; F.ws = a.ws; F.ar = a.ws + WS_AR;
    F.tid = threadIdx.x; F.lane = F.tid & 63; F.wave = __builtin_amdgcn_readfirstlane(F.tid >> 6); F.bx = blockIdx.x;
    F.G = gridDim.x; F.gw = blockIdx.x * NWAVES + F.wave; F.NGW = F.G * NWAVES;
    {
        const float** const tab0 = (const float**)(a.ws + 64);
        if (F.tid == 0 && blockIdx.x == 0) {
            tab0[0] = a.in[0]; tab0[1] = a.in[1]; tab0[2] = a.in[2]; tab0[3] = a.in[3]; tab0[4] = a.in[4]; tab0[5] = a.in[5]; tab0[6] = a.in[6]; tab0[7] = a.in[7];
            tab0[8] = a.in[8]; tab0[9] = a.in[9]; tab0[10] = a.in[10]; tab0[11] = a.in[11]; tab0[12] = a.in[12]; tab0[13] = a.in[13]; tab0[14] = a.in[14]; tab0[15] = a.in[15];
            *(unsigned*)(a.ws + 1024) = 0u;
            tab0[16] = a.in[16]; tab0[17] = a.in[17]; tab0[18] = a.in[18]; tab0[19] = a.in[19]; tab0[20] = a.in[20]; tab0[21] = a.in[21]; tab0[22] = a.in[22]; tab0[23] = a.in[23];
        }
    }
    if (blockIdx.x == 0) for (int i = threadIdx.x; i < XCD_BAR_WORDS; i += NWAVES * 64) ((unsigned*)(a.ws + 4096))[i] = 0u;
#define TAB(i) (tab[(i)])
    convert_weights(F, a.in[2], a.in[18], a.in[3], a.in[19], a.in[20], a.in[21], a.in[6], a.in[14], a.in[11], a.in[15], a.in[12], 0, true);
    cvt_rows(F, a.in[0], (bf16*)(a.ws + WS_XB), (size_t)M * D);
    grid.sync();

    volatile int* const ctl = (volatile int*)(lds_raw + LDS_BYTES - 16);
    volatile LAS unsigned* const bst = (volatile LAS unsigned*)((LAS unsigned char*)lds_raw + LDS_BYTES - 32);
    if (threadIdx.x == 0) { ctl[0] = 0; bst[0] = 0u; bst[1] = 0u; }
    __syncthreads();
    (void)xcd_barrier_post((unsigned*)(a.ws + 4096), bst);
    for (;;) {
        {
            const int step = __builtin_amdgcn_readfirstlane(ctl[0]);
            if (step >= 49) break;
            const int L = (step < 13) ? 0 : (step < 26 ? 1 : (step < 38 ? 2 : 3));
            const int st = step - ((L == 0) ? 0 : (L == 1 ? 13 : (L == 2 ? 26 : 38)));
            const unsigned long long prog = (L < 2) ? 0xCBA9876543210ull : (L == 2 ? 0xCBA987FE210Dull : 0xCBA987FE210ull);
            const int code = (int)((prog >> (4 * st)) & 15ull);
#define STEP_FRAME() \
            const unsigned char* ka = (const unsigned char*)__builtin_amdgcn_kernarg_segment_ptr(); \
            unsigned char* ws = *(unsigned char* const volatile*)(ka + 25 * 8); float* X = *(float* const volatile*)(ka + 24 * 8); \
            F.lds = lds_raw; F.ws = ws; F.ar = ws + WS_AR; \
            { int t_ = threadIdx.x, b_ = blockIdx.x, g_ = gridDim.x; asm volatile("" : "+v"(t_), "+s"(b_), "+s"(g_)); F.tid = t_; F.bx = b_; F.G = g_; } \
            F.lane = F.tid & 63; F.wave = __builtin_amdgcn_readfirstlane(F.tid >> 6); \
            F.gw = F.bx * NWAVES + F.wave; F.NGW = F.G * NWAVES; \
            LAS unsigned char* lds3 = (LAS unsigned char*)lds_raw; \
            const float** const tab = (const float**)(ws + 64); \
            bf16* const Wb = (bf16*)(ws + WS_W); bf16* const XB = (bf16*)(ws + WS_XB); bf16* const HB = (bf16*)(F.ar + AR_H); bf16* const PB = (bf16*)(F.ar + AR_PB); bf16* const PLEB = (bf16*)(F.ar + AR_PLE); \
            bf16* const KSH = (bf16*)(F.ar + AR_KSH); bf16* const VSH = (bf16*)(F.ar + AR_VSH); float* const CSH = (float*)(F.ar + AR_CSH); float* const FLOG = (float*)(F.ar + AR_FLOG); \
            (void)lds3; (void)tab; (void)Wb; (void)XB; (void)HB; (void)PB; (void)PLEB; (void)KSH; (void)VSH; (void)CSH; (void)FLOG; (void)X;
            switch (code) {
#ifndef NO_SWIGLU
            case 0: case 10: { STEP_FRAME()
#ifndef NO_PLE
                if (code == 10) {
                    pg8::Gemm g{XB, Wb + OW_PG, M, D, D}; pg8::StaticOrder S; S.init(M, D, F.G, F.bx);
                    pg8::EpiPle E{PLEB};
                    pg8::gemm_phase<pg8::EpiPle, pg8::StaticOrder, PG8_ALIGN, PG8_SP2>(lds3, g, S, E);
                }
#endif
                pg8::Gemm g{XB, Wb + (code == 0 ? OW_F1IN : OW_F2IN), M, 2 * FF, D}; pg8::StaticOrder S; S.init(M, 2 * FF, F.G, F.bx);
                pg8::EpiSwiGLU E{HB, FF};
#ifdef PROBE_DOUBLE_SWIGLU
                for (int rep_ = 0; rep_ < 2; ++rep_)
#endif
                pg8::gemm_phase<pg8::EpiSwiGLU, pg8::StaticOrder, PG8_ALIGN, PG8_SP2>(lds3, g, S, E);
            } break;
#endif
#ifndef NO_RES
            case 1: case 7: case 11: { STEP_FRAME()
                const bf16* A = (code == 7) ? ((L < 2) ? (const bf16*)(F.ar + AR_GV) : (const bf16*)(F.ar + AR_FO)) : HB;
                const bf16* Wt = Wb + (code == 1 ? OW_F1OUT : (code == 7 ? OW_MIXO : OW_F2OUT));
                const int K = (code == 7) ? D : FF;
                const bool first = (L == 0 && code == 1);
                const float* base = first ? TAB(0) : X;
                const int gi = (code == 7) ? 4 : (code == 11 ? 16 : 22); const int Lg = (code == 1) ? L - 1 : L;
                const float* lg = first ? nullptr : TAB(gi) + Lg * D; const float* lb = first ? nullptr : TAB(gi + 1) + Lg * D;
                pg8::Gemm g{A, Wt, M, D, K}; pg8::StaticOrder S; S.init(M, D, F.G, F.bx);
                pg8::EpiRes E{base, X, (code == 11) ? PLEB : nullptr, DN_ALPHA, (code == 7) ? 1.f : 0.5f, first ? nullptr : (const float*)(ws + 65536), lg, lb};
                pg8::gemm_phase<pg8::EpiRes, pg8::StaticOrder, PG8_ALIGN, PG8_SP2>(lds3, g, S, E);
            } break;
#endif
#ifndef NO_LN
            case 2: case 8: case 12: { STEP_FRAME()
                const int gi = (code == 2) ? 4 : (code == 8 ? 16 : 22);
                ln_phase(F, TAB(gi) + L * D, TAB(gi + 1) + L * D, X, XB, (float*)(ws + 65536), code == 12 && L == DEPTH - 1);
                if (code == 2 && L == 2) { cumsum_phase(F, FLOG, CSH); kmax_phase(F, KSH, (unsigned*)(ws + 1024)); }
                if (code == 8) cvt_rows(F, TAB(1) + (size_t)L * M * PLE, PB, (size_t)M * PLE);
                if (code == 12 && L + 1 < DEPTH) convert_weights(F, TAB(2), TAB(18), TAB(3), TAB(19), TAB(20), TAB(21), TAB(6), TAB(14), TAB(11), TAB(15), TAB(12), L + 1, false);
            } break;
#endif
#ifndef NO_SPLIT
            case 3: case 9: case 13: case 14: { STEP_FRAME()
                const int mode = (code == 3) ? 0 : (code == 9 ? 1 : (code == 13 ? 2 : 3));
                const pg8::Gemm g{(code == 9) ? PB : XB, Wb + (code == 9 ? OW_PP : (code == 13 ? OW_KVF : OW_MIXIN)), M, (code == 3) ? GLA_INP : (code == 9 ? D : (code == 13 ? KVF_NP : 2048)), (code == 9) ? PLE : D};
                const pg8::EpiSplit E{F.ar, mode, TAB(13)};
                pg8::StaticOrder S; S.init(g.M, g.N, F.G, F.bx);
                pg8::gemm_phase<pg8::EpiSplit, pg8::StaticOrder, PG8_ALIGN, PG8_SP2>(lds3, g, S, E);
            } break;
#endif
#ifndef NO_PREP
            case 4: { STEP_FRAME() gla_prep(F, TAB(7) + (size_t)L * 16 * 512, TAB(8) + L * 512); } break;
#endif
#ifndef NO_SCAN
            case 5: { STEP_FRAME() gla_scan(F);
#ifdef PROBE_DOUBLE_SCAN
                gla_scan(F);
#endif
            } break;
#endif
#ifndef NO_OUT
            case 6: { STEP_FRAME() gla_out(F, TAB(9) + L * D, TAB(10) + L * D);
#ifdef PROBE_DOUBLE_OUT
                gla_out(F, TAB(9) + L * D, TAB(10) + L * D);
#endif
            } break;
#endif
#ifndef NO_ATTN
            case 15: { STEP_FRAME()
                const attn_body::AttnTensors AT{(const attn_body::bf16*)(F.ar + AR_FQ), (const attn_body::bf16*)KSH, (const attn_body::bf16*)VSH, (attn_body::bf16*)(F.ar + AR_FO),
                                                (const attn_body::bf16*)(F.ar + AR_FG), CSH, sqrtf(*(const float*)(ws + 1024))};
                const attn_body::StaticOrder S((int)F.G, F.bx);
                attn_body::attn_phase<attn_body::StaticOrder>((char*)lds_raw, AT, S);
#ifdef PROBE_DOUBLE_ATTN
                attn_body::attn_phase<attn_body::StaticOrder>((char*)lds_raw, AT, S);
#endif
            } break;
#endif
            default: break;
            }
        }
        if (threadIdx.x == 0) ctl[0] = ctl[0] + 1;
#ifdef USE_CG_SYNC
        grid.sync();
#else
        { const unsigned char* ka2 = (const unsigned char*)__builtin_amdgcn_kernarg_segment_ptr();
          XcdBarrier xb; xb.bar = (unsigned*)(*(unsigned char* const volatile*)(ka2 + 25 * 8) + 4096); xb.x = xb_xcc_id(); xb.st = (volatile LAS unsigned*)((LAS unsigned char*)lds_raw + LDS_BYTES - 32);
          xcd_barrier(xb);
#ifdef PROBE_DOUBLE_SYNC
          xcd_barrier(xb); xcd_barrier(xb); xcd_barrier(xb); xcd_barrier(xb);
#endif
          }
#endif

    }
}

extern "C" void kernel_launch(void* const* d_in, const int* in_sizes, int n_in, void* d_out, int out_size, void* d_ws, size_t ws_size, hipStream_t stream) {
    static int grid = 0;
    if (grid == 0) {
        if (n_in != 24 || out_size != M * D || ws_size < WS_END) { fprintf(stderr, "kernel_launch: unexpected shapes (n_in %d, out %d, ws %zu)\n", n_in, out_size, ws_size); grid = -1; return; }
        int dev = 0, cus = 0, per_cu = 0;
        if (hipGetDevice(&dev) != hipSuccess || hipDeviceGetAttribute(&cus, hipDeviceAttributeMultiprocessorCount, dev) != hipSuccess) { grid = -1; return; }
        if (hipFuncSetAttribute((const void*)yoco_fwd, hipFuncAttributeMaxDynamicSharedMemorySize, LDS_BYTES) != hipSuccess) { fprintf(stderr, "kernel_launch: hipFuncSetAttribute failed\n"); grid = -1; return; }
        if (hipOccupancyMaxActiveBlocksPerMultiprocessor(&per_cu, (const void*)yoco_fwd, NWAVES * 64, LDS_BYTES) != hipSuccess || per_cu < 1) per_cu = 1;
        (void)hipGetLastError();
        grid = cus * per_cu;
    }
    if (grid < 0) return;
    Args a{};
    for (int i = 0; i < 24; ++i) a.in[i] = (const float*)d_in[i];
    a.out = (float*)d_out; a.ws = (unsigned char*)d_ws;
    void* args[] = {&a};
    const hipError_t e = hipLaunchCooperativeKernel((const void*)yoco_fwd, dim3(grid), dim3(NWAVES * 64), args, LDS_BYTES, stream);
    if (e != hipSuccess) fprintf(stderr, "kernel_launch: cooperative launch failed: %s (grid %d)\n", hipGetErrorString(e), grid);
}
```
